# Optimizing an MI355X kernel written in HIP

```python
import math
import numpy as np
import jax
import jax.numpy as jnp
from jax import lax

D_MODEL = 1024
BATCH = 8
SEQ = 4096
DEPTH = 1

EPS = 1e-6
DN_HEADS = 8
DN_HEAD_DIM = 128
DN_WIDTH = DN_HEADS * DN_HEAD_DIM
CONV_WIDTH = 4
CHUNK = 64
ATT_GROUPS = ((128, 1), (512, 4), (2048, 16))
ATT_HEADS_PER_GROUP = 4
ATT_HEAD_DIM = 128
ATT_N_HEADS = len(ATT_GROUPS) * ATT_HEADS_PER_GROUP
ATT_WIDTH = ATT_N_HEADS * ATT_HEAD_DIM
ATT_OUT_WIDTH = ATT_HEADS_PER_GROUP * ATT_HEAD_DIM
ATT_BLOCK = 128
ROPE_THETA = 500000.0
ROPE_DIM = ATT_HEAD_DIM // 4
D_FF = -(-8 * D_MODEL // (3 * 256)) * 256
IN_SIZES = (DN_WIDTH, DN_WIDTH, DN_WIDTH, DN_WIDTH, DN_HEADS, DN_HEADS,
            ATT_WIDTH, ATT_WIDTH, ATT_WIDTH, D_MODEL, D_MODEL)
IN_DIM = sum(IN_SIZES)

kernel_name = "hybrid_gated_deltanet_dilated_attn_block"


def rms_norm(x, w):
    x32 = x.astype(jnp.float32)
    y = x32 * lax.rsqrt(jnp.mean(x32 * x32, axis=-1, keepdims=True) + EPS)
    return (y * w.astype(jnp.float32)).astype(x.dtype)


def l2_normalize(x):
    x32 = x.astype(jnp.float32)
    return x32 * lax.rsqrt(jnp.sum(x32 * x32, axis=-1, keepdims=True) + EPS)


def causal_depthwise_conv(x, w):
    k_width = w.shape[0]
    seq = x.shape[1]
    xp = jnp.pad(x, ((0, 0), (k_width - 1, 0), (0, 0)))
    return sum(xp[:, j:j + seq] * w[j] for j in range(k_width))


def _to_chunks(t, n_chunks):
    b, _, h = t.shape[:3]
    t = t.reshape((b, n_chunks, CHUNK, h) + t.shape[3:])
    return jnp.swapaxes(jnp.swapaxes(t, 0, 1), 2, 3)


def gated_delta_rule(q, k, v, g, beta):
    f32 = jnp.float32
    b, seq, h, dk = q.shape
    dv = v.shape[-1]
    n = seq // CHUNK
    q, k, v = (_to_chunks(t.astype(f32), n) for t in (q, k, v))
    g, beta = (_to_chunks(t.astype(f32), n) for t in (g, beta))
    gc = jnp.cumsum(g, axis=-1)
    idx = jnp.arange(CHUNK)
    causal = idx[:, None] >= idx[None, :]
    strict = idx[:, None] > idx[None, :]
    decay = jnp.exp(jnp.where(causal, gc[..., :, None] - gc[..., None, :], -jnp.inf))
    kb = k * beta[..., None]
    vb = v * beta[..., None]
    a = jnp.where(strict, jnp.einsum('nbhcd,nbhsd->nbhcs', kb, k) * decay, 0.0)
    eye = jnp.eye(CHUNK, dtype=f32)
    t_inv = lax.linalg.triangular_solve(a + eye, jnp.broadcast_to(eye, a.shape),
                                        left_side=True, lower=True, unit_diagonal=True)
    u = jnp.einsum('nbhcs,nbhse->nbhce', t_inv, vb)
    w = jnp.einsum('nbhcs,nbhsd->nbhcd', t_inv, kb * jnp.exp(gc)[..., None])
    qk = jnp.einsum('nbhcd,nbhsd->nbhcs', q, k) * decay
    q_dec = q * jnp.exp(gc)[..., None]
    k_dec = k * jnp.exp(gc[..., -1:] - gc)[..., None]
    g_last = jnp.exp(gc[..., -1])

    def step(state, xs):
        u_n, w_n, qk_n, qd_n, kd_n, gl_n = xs
        v_new = u_n - jnp.einsum('bhcd,bhde->bhce', w_n, state)
        o_n = jnp.einsum('bhcd,bhde->bhce', qd_n, state) + jnp.einsum('bhcs,bhse->bhce', qk_n, v_new)
        state = state * gl_n[..., None, None] + jnp.einsum('bhcd,bhce->bhde', kd_n, v_new)
        return state, o_n

    s0 = jnp.zeros((b, h, dk, dv), f32)
    _, o = lax.scan(step, s0, (u, w, qk, q_dec, k_dec, g_last))
    o = jnp.swapaxes(jnp.swapaxes(o, 2, 3), 0, 1)
    return o.reshape(b, seq, h, dv)


def partial_rope(x, positions):
    half = ROPE_DIM // 2
    inv_freq = jnp.power(ROPE_THETA, -jnp.arange(half, dtype=jnp.float32) * (2.0 / ROPE_DIM))
    ang = positions.astype(jnp.float32)[:, None] * inv_freq[None, :]
    cos = jnp.cos(ang)[None, :, None, :]
    sin = jnp.sin(ang)[None, :, None, :]
    x1 = x[..., :half].astype(jnp.float32)
    x2 = x[..., half:ROPE_DIM].astype(jnp.float32)
    rest = x[..., ROPE_DIM:].astype(jnp.float32)
    return jnp.concatenate([x1 * cos - x2 * sin, x2 * cos + x1 * sin, rest], axis=-1).astype(x.dtype)


def dilated_window_attention(q, k, v, window, dilation):
    b, seq, h, d = q.shape
    n_keys = window // dilation
    span = dilation * ATT_BLOCK
    lp = -(-seq // span) * span
    m_len = lp // dilation
    nb = m_len // ATT_BLOCK

    def to_blocks(t):
        t = jnp.pad(t, ((0, 0), (0, lp - seq), (0, 0), (0, 0)))
        t = jnp.swapaxes(t.reshape(b, m_len, dilation, h, d), 1, 2)
        return t.reshape(b, dilation, nb, ATT_BLOCK, h, d)

    def with_prev(t):
        prev = jnp.pad(t, ((0, 0), (0, 0), (1, 0), (0, 0), (0, 0), (0, 0)))[:, :, :-1]
        return jnp.concatenate([prev, t], axis=3)

    def from_blocks(t):
        t = t.reshape((b, dilation, m_len) + t.shape[4:])
        t = jnp.swapaxes(t, 1, 2)
        return t.reshape((b, lp) + t.shape[3:])[:, :seq]

    qb = to_blocks(q)
    kc = with_prev(to_blocks(k))
    vc = with_prev(to_blocks(v))
    s = jnp.einsum('brnqhd,brnkhd->brnhqk', qb, kc, preferred_element_type=jnp.float32) * (d ** -0.5)
    qi = jnp.arange(ATT_BLOCK)[:, None]
    kj = jnp.arange(2 * ATT_BLOCK)[None, :]
    dist = qi + ATT_BLOCK - kj
    blk = jnp.arange(nb)[:, None, None]
    valid = (dist >= 0) & (dist <= n_keys) & ((blk > 0) | (kj >= ATT_BLOCK))
    s = jnp.where(valid[:, None], s, -jnp.inf)
    m = jnp.max(s, axis=-1, keepdims=True)
    p = jnp.exp(s - m)
    den = jnp.sum(p, axis=-1, keepdims=True)
    o = jnp.einsum('brnhqk,brnkhd->brnqhd', p / den, vc.astype(jnp.float32))
    lse = jnp.swapaxes((m + jnp.log(den))[..., 0], 3, 4)
    return from_blocks(o), from_blocks(lse)


def setup_inputs(seed: int = 0) -> dict:
    key = jax.random.key(seed)
    ks = jax.random.split(key, 16)
    f32 = jnp.float32

    def dense(k, shape, fan_in):
        return jax.random.normal(k, shape, f32) * (fan_in ** -0.5)

    def gain(k, shape):
        return 1.0 + 0.02 * jax.random.normal(k, shape, f32)

    x = jax.random.normal(ks[0], (BATCH, SEQ, D_MODEL), f32)
    norm1_w = gain(ks[1], (DEPTH, D_MODEL))
    w_in = dense(ks[2], (DEPTH, D_MODEL, IN_DIM), D_MODEL)
    conv_w = dense(ks[3], (DEPTH, CONV_WIDTH, 3 * DN_WIDTH), CONV_WIDTH)
    a_log = jnp.log(jax.random.uniform(ks[4], (DEPTH, DN_HEADS), f32, minval=1.0, maxval=16.0))
    dt = jnp.exp(jax.random.uniform(ks[5], (DEPTH, DN_HEADS), f32,
                                    minval=math.log(1e-3), maxval=math.log(1e-1)))
    dt_bias = dt + jnp.log(-jnp.expm1(-dt))
    dn_norm_w = gain(ks[6], (DEPTH, DN_HEAD_DIM))
    w_proj_a = dense(ks[7], (DEPTH, DN_WIDTH, D_MODEL), DN_WIDTH)
    w_proj_b = dense(ks[8], (DEPTH, ATT_OUT_WIDTH, D_MODEL), ATT_OUT_WIDTH)
    w_out = dense(ks[9], (DEPTH, D_MODEL, D_MODEL), D_MODEL)
    norm2_w = gain(ks[10], (DEPTH, D_MODEL))
    w_gate_up = dense(ks[11], (DEPTH, D_MODEL, 2 * D_FF), D_MODEL)
    w_down = dense(ks[12], (DEPTH, D_FF, D_MODEL), D_FF)
    final_norm_w = gain(ks[13], (D_MODEL,))
    return {"x": x, "norm1_w": norm1_w, "w_in": w_in, "conv_w": conv_w, "a_log": a_log,
            "dt_bias": dt_bias, "dn_norm_w": dn_norm_w, "w_proj_a": w_proj_a, "w_proj_b": w_proj_b,
            "w_out": w_out, "norm2_w": norm2_w, "w_gate_up": w_gate_up, "w_down": w_down,
            "final_norm_w": final_norm_w}


def reference(x, norm1_w, w_in, conv_w, a_log, dt_bias, dn_norm_w, w_proj_a, w_proj_b,
              w_out, norm2_w, w_gate_up, w_down, final_norm_w):
    f32 = jnp.float32
    b, seq, _ = x.shape
    positions = jnp.arange(seq)
    splits = np.cumsum(IN_SIZES)[:-1].tolist()
    for i in range(DEPTH):
        h = rms_norm(x, norm1_w[i])
        proj = h @ w_in[i]
        dq, dk, dv, dz, db, da, aq, ak, av, ga, gb = jnp.split(proj, splits, axis=-1)

        qkv = jax.nn.silu(causal_depthwise_conv(jnp.concatenate([dq, dk, dv], axis=-1), conv_w[i]))
        cq, ck, cv = jnp.split(qkv, 3, axis=-1)
        q = l2_normalize(cq.reshape(b, seq, DN_HEADS, DN_HEAD_DIM)) * (DN_HEAD_DIM ** -0.5)
        k = l2_normalize(ck.reshape(b, seq, DN_HEADS, DN_HEAD_DIM))
        v = cv.reshape(b, seq, DN_HEADS, DN_HEAD_DIM)
        beta = jax.nn.sigmoid(db.astype(f32))
        g = -jnp.exp(a_log[i].astype(f32)) * jax.nn.softplus(da.astype(f32) + dt_bias[i].astype(f32))
        o_a = gated_delta_rule(q, k, v, g, beta)
        o_a = rms_norm(o_a, dn_norm_w[i]) * jax.nn.silu(dz.reshape(b, seq, DN_HEADS, DN_HEAD_DIM).astype(f32))
        y_a = o_a.reshape(b, seq, DN_WIDTH).astype(x.dtype) @ w_proj_a[i]

        qr = partial_rope(aq.reshape(b, seq, ATT_N_HEADS, ATT_HEAD_DIM), positions)
        kr = partial_rope(ak.reshape(b, seq, ATT_N_HEADS, ATT_HEAD_DIM), positions)
        vv = av.reshape(b, seq, ATT_N_HEADS, ATT_HEAD_DIM)
        outs, lses = [], []
        for gi, (window, dil) in enumerate(ATT_GROUPS):
            sl = slice(gi * ATT_HEADS_PER_GROUP, (gi + 1) * ATT_HEADS_PER_GROUP)
            o_g, lse_g = dilated_window_attention(qr[:, :, sl], kr[:, :, sl], vv[:, :, sl], window, dil)
            outs.append(o_g)
            lses.append(lse_g)
        alpha = jax.nn.softmax(jnp.stack(lses), axis=0)
        o_b = jnp.sum(alpha[..., None] * jnp.stack(outs), axis=0)
        y_b = o_b.reshape(b, seq, ATT_OUT_WIDTH).astype(x.dtype) @ w_proj_b[i]

        merged = jax.nn.sigmoid(ga) * y_a + jax.nn.sigmoid(gb) * y_b
        x = x + merged @ w_out[i]

        h2 = rms_norm(x, norm2_w[i])
        gate, up = jnp.split(h2 @ w_gate_up[i], 2, axis=-1)
        x = x + (jax.nn.silu(gate) * up) @ w_down[i]
    return rms_norm(x, final_norm_w)
```

```cpp
#include <hip/hip_runtime.h>
#include <hip/hip_cooperative_groups.h>
#include <cstdio>
#include <cstdint>
namespace cg = cooperative_groups;
namespace pg8 {
#define PG8_LAS __attribute__((address_space(3)))
typedef unsigned short bf16_t;
typedef short bf16x8 __attribute__((ext_vector_type(8)));
typedef float f32x4 __attribute__((ext_vector_type(4)));
typedef unsigned u32x4 __attribute__((ext_vector_type(4)));
constexpr int BM = 256, BK = 64, HALF = 128, HTB = HALF * BK * 2  , STAGE_BYTES = 8 * HTB, NXCD = 8, WGM = 8;

__host__ __device__ __forceinline__ int lds_byte(int r, int c) { const int st = (r >> 4) * 2 + (c >> 5), rr = r & 15, cc = c & 31, ob = rr * 64 + cc * 2; return st * 1024 + (ob ^ (((ob >> 9) & 1) << 5)); }
__host__ __device__ __forceinline__ void stage_rc(int b, int& R, int& C) { const int st = b / 1024, sb = b % 1024, swz = sb ^ (((sb >> 9) & 1) << 5); R = (st >> 1) * 16 + swz / 64; C = (st & 1) * 32 + (swz % 64) / 2; }
__host__ __device__ __forceinline__ int perm32(int rho) { const int n = rho >> 4, i = rho & 15; return 8 * (i >> 2) + 4 * n + (i & 3); }

struct Unit { int pm, pn; };
struct Gemm { const bf16_t* A; const bf16_t* Bt; int M, N, K, wv; };

struct StaticOrder {
    int nM, nN, nwg, G, c;
    __host__ __device__ void init(int M, int N, int G_, int c_) { nM = M / BM; nN = N / BM; nwg = nM * nN; G = G_; c = c_; }
    __host__ __device__ bool next(int i, Unit& u) const {
        const long L = (long)i * G + c; if (L >= nwg) return false;
        int wgid = (int)L; { const int q = nwg / NXCD, r = nwg % NXCD, xcd = wgid % NXCD, off = wgid / NXCD; wgid = (xcd < r ? xcd * (q + 1) : r * (q + 1) + (xcd - r) * q) + off; }
        const int nig = WGM * nN, gid = wgid / nig, fm = gid * WGM, gsz = (nM - fm) < WGM ? (nM - fm) : WGM;
        u.pm = fm + ((wgid % nig) % gsz); u.pn = (wgid % nig) / gsz; return true;
    }
    __device__ __forceinline__ void a_ready(const Unit&) const {}
    __device__ __forceinline__ void done(const Unit&) const {}
};

template <class Epi, class Sched, bool ALIGN_EPI = false, bool SP2 = false>
__device__ __forceinline__ void gemm_phase(PG8_LAS unsigned char* lds, const Gemm g, const Sched& S, const Epi& E) {
    int ln_; asm volatile("v_mbcnt_lo_u32_b32 %0, -1, 0\n\tv_mbcnt_hi_u32_b32 %0, -1, %0" : "=v"(ln_)); int tid_ = (g.wv << 6) | ln_; const int tid = tid_, wid = __builtin_amdgcn_readfirstlane(tid >> 6), lane = tid & 63, wr = wid >> 2, wc = wid & 3, fr = lane & 15, fq = lane >> 4;
    const int K = g.K, nt = K / BK;
    unsigned voffA[2], voffB[2];
#pragma unroll
    for (int i = 0; i < 2; ++i) { int R, C; stage_rc(tid * 16 + i * 8192, R, C); const int Rb = Epi::PERM ? ((R & ~31) + perm32(R & 31)) : R;
        voffA[i] = (unsigned)(R * K + C) * 2u; voffB[i] = (unsigned)(Rb * K + C) * 2u; }
    const size_t kstep = (size_t)(BK * 2);
    const size_t hstep = (size_t)HALF * K * 2;
    const size_t tstep = 2 * hstep;
    const unsigned ldsw = (unsigned)wid * 1024u;
    const int aoff = lds_byte(wr * 64 + fr, fq * 8), boff = lds_byte(wc * 32 + fr, fq * 8);
#define PG8_SA(b, h) (((b) * 2 + (h)) * HTB)
#define PG8_SB(b, h) ((4 + (b) * 2 + (h)) * HTB)
#define PG8_STAGE(bufoff, gbase, voff) do { _Pragma("unroll") for (int _i = 0; _i < 2; ++_i) \
        __builtin_amdgcn_global_load_lds((const unsigned*)((const char*)(gbase) + (voff)[_i]), (PG8_LAS unsigned*)(lds + (bufoff) + ldsw + _i * 8192), 16, 0, 0); } while (0)
#define PG8_LDA(dst, b, h) do { _Pragma("unroll") for (int m = 0; m < 4; ++m) _Pragma("unroll") for (int k = 0; k < 2; ++k) dst[m][k] = *(const PG8_LAS bf16x8*)(lds + PG8_SA(b, h) + aoff + m * 2048 + k * 1024); } while (0)
#define PG8_LDB(dst, b, h) do { _Pragma("unroll") for (int n = 0; n < 2; ++n) _Pragma("unroll") for (int k = 0; k < 2; ++k) dst[n][k] = *(const PG8_LAS bf16x8*)(lds + PG8_SB(b, h) + boff + n * 2048 + k * 1024); } while (0)
#define PG8_MMA(ai, bj, At, Bt) do { __builtin_amdgcn_s_setprio(1); _Pragma("unroll") for (int m = 0; m < 4; ++m) _Pragma("unroll") for (int n = 0; n < 2; ++n) _Pragma("unroll") for (int k = 0; k < 2; ++k) \
        acc[ai][bj][m][n] = __builtin_amdgcn_mfma_f32_16x16x32_bf16(Bt[n][k], At[m][k], acc[ai][bj][m][n], 0, 0, 0); __builtin_amdgcn_s_setprio(0); } while (0)
#define PG8_WAIT_V(n) asm volatile("s_waitcnt vmcnt(" #n ")" ::: "memory")
#define PG8_WAIT_L(n) asm volatile("s_waitcnt lgkmcnt(" #n ")" ::: "memory")
#define PG8_BAR __builtin_amdgcn_s_barrier()
#define PG8_SCHED __builtin_amdgcn_sched_barrier(0)
    Unit cur, nxt; int ui = 0;
    if (!S.next(0, cur)) return;
    f32x4 acc[2][2][4][2];
#pragma unroll
    for (int a = 0; a < 2; ++a)
#pragma unroll
        for (int b = 0; b < 2; ++b)
#pragma unroll
            for (int m = 0; m < 4; ++m)
#pragma unroll
                for (int n = 0; n < 2; ++n) acc[a][b][m][n] = (f32x4){0.f, 0.f, 0.f, 0.f};
    bf16x8 At[4][2], B0[2][2], B1[2][2];
    const char* cA = (const char*)g.A + (size_t)cur.pm * tstep; const char* cB = (const char*)g.Bt + (size_t)cur.pn * tstep;
    S.a_ready(cur);
    if constexpr (SP2) {
        PG8_STAGE(PG8_SB(0, 0), cB, voffB); PG8_STAGE(PG8_SB(0, 1), cB + hstep, voffB); PG8_STAGE(PG8_SA(0, 0), cA, voffA); PG8_STAGE(PG8_SA(0, 1), cA + hstep, voffA);
        if (wr == 1) PG8_BAR;
        PG8_WAIT_V(2); PG8_BAR;
        PG8_STAGE(PG8_SB(1, 0), cB + kstep, voffB); PG8_STAGE(PG8_SA(1, 0), cA + kstep, voffA); PG8_STAGE(PG8_SB(1, 1), cB + hstep + kstep, voffB);
        PG8_WAIT_V(6); PG8_BAR;
    } else {
        PG8_STAGE(PG8_SB(0, 0), cB, voffB); PG8_STAGE(PG8_SA(0, 0), cA, voffA); PG8_STAGE(PG8_SB(0, 1), cB + hstep, voffB); PG8_STAGE(PG8_SA(0, 1), cA + hstep, voffA);
        if (wr == 1) PG8_BAR;
        PG8_WAIT_V(4); PG8_BAR;
        PG8_STAGE(PG8_SB(1, 0), cB + kstep, voffB); PG8_STAGE(PG8_SA(1, 0), cA + kstep, voffA); PG8_STAGE(PG8_SB(1, 1), cB + hstep + kstep, voffB);
        PG8_WAIT_V(6); PG8_BAR;
    }
    for (;;) {
        const bool has_next = S.next(ui + 1, nxt);
        const char* nA = has_next ? (const char*)g.A + (size_t)nxt.pm * tstep : cA; const char* nB = has_next ? (const char*)g.Bt + (size_t)nxt.pn * tstep : cB;
        for (int t = 0; t < nt; t += 2) {
            const bool last = (t == nt - 2);
            const char* a1 = cA + (size_t)(t + 1) * kstep;
            const char* a2 = last ? nA : cA + (size_t)(t + 2) * kstep; const char* b2 = last ? nB : cB + (size_t)(t + 2) * kstep;
            const char* a3 = a2 + kstep; const char* b3 = b2 + kstep;
            if (last && has_next) S.a_ready(nxt);
            if constexpr (SP2) {
            PG8_LDB(B0, 0, 0); PG8_LDB(B1, 0, 1); PG8_SCHED; PG8_LDA(At, 0, 0); PG8_STAGE(PG8_SA(1, 1), a1 + hstep, voffA);
            PG8_WAIT_V(8); PG8_WAIT_L(0); PG8_BAR; PG8_MMA(0, 0, At, B0); PG8_MMA(0, 1, At, B1); PG8_BAR; PG8_SCHED;
            PG8_LDA(At, 0, 1); PG8_STAGE(PG8_SB(0, 0), b2, voffB); PG8_STAGE(PG8_SB(0, 1), b2 + hstep, voffB); PG8_STAGE(PG8_SA(0, 0), a2, voffA);
            PG8_WAIT_V(8); PG8_WAIT_L(0); PG8_BAR; PG8_MMA(1, 0, At, B0); PG8_MMA(1, 1, At, B1); PG8_BAR; PG8_SCHED;
            PG8_LDB(B0, 1, 0); PG8_LDB(B1, 1, 1); PG8_SCHED; PG8_LDA(At, 1, 0); PG8_STAGE(PG8_SA(0, 1), a2 + hstep, voffA);
            PG8_WAIT_V(8); PG8_WAIT_L(0); PG8_BAR; PG8_MMA(0, 0, At, B0); PG8_MMA(0, 1, At, B1); PG8_BAR; PG8_SCHED;
            PG8_LDA(At, 1, 1); PG8_STAGE(PG8_SB(1, 0), b3, voffB); PG8_STAGE(PG8_SB(1, 1), b3 + hstep, voffB); PG8_STAGE(PG8_SA(1, 0), a3, voffA);
            PG8_WAIT_V(8); PG8_WAIT_L(0); PG8_BAR; PG8_MMA(1, 0, At, B0); PG8_MMA(1, 1, At, B1); PG8_BAR; PG8_SCHED;
            } else {
            PG8_LDB(B0, 0, 0); PG8_SCHED; PG8_LDA(At, 0, 0); PG8_STAGE(PG8_SA(1, 1), a1 + hstep, voffA);
            PG8_WAIT_L(8); PG8_BAR; PG8_WAIT_L(0); PG8_MMA(0, 0, At, B0); PG8_BAR; PG8_SCHED;
            PG8_LDB(B1, 0, 1); PG8_STAGE(PG8_SB(0, 0), b2, voffB);
            PG8_BAR; PG8_WAIT_L(0); PG8_MMA(0, 1, At, B1); PG8_BAR;
            PG8_LDA(At, 0, 1); PG8_STAGE(PG8_SA(0, 0), a2, voffA);
            PG8_BAR; PG8_WAIT_L(0); PG8_MMA(1, 0, At, B0); PG8_BAR; PG8_SCHED;
            PG8_STAGE(PG8_SB(0, 1), b2 + hstep, voffB);
            PG8_WAIT_V(6); PG8_BAR; PG8_MMA(1, 1, At, B1); PG8_BAR;
            PG8_LDB(B0, 1, 0); PG8_SCHED; PG8_LDA(At, 1, 0); PG8_STAGE(PG8_SA(0, 1), a2 + hstep, voffA);
            PG8_WAIT_L(8); PG8_BAR; PG8_WAIT_L(0); PG8_MMA(0, 0, At, B0); PG8_BAR; PG8_SCHED;
            PG8_LDB(B1, 1, 1); PG8_STAGE(PG8_SB(1, 0), b3, voffB);
            PG8_BAR; PG8_WAIT_L(0); PG8_MMA(0, 1, At, B1); PG8_BAR;
            PG8_LDA(At, 1, 1); PG8_STAGE(PG8_SA(1, 0), a3, voffA);
            PG8_BAR; PG8_WAIT_L(0); PG8_MMA(1, 0, At, B0); PG8_BAR; PG8_SCHED;
            PG8_STAGE(PG8_SB(1, 1), b3 + hstep, voffB);
            PG8_WAIT_V(6); PG8_BAR; PG8_MMA(1, 1, At, B1); PG8_BAR;
            }
        }
        if constexpr (ALIGN_EPI) { if (wr == 0) PG8_BAR; }
        if constexpr (!Epi::AFTER_DRAIN) { E(acc, cur, wr, wc, fr, fq); S.done(cur); }
        if (!has_next) break;
#pragma unroll
        for (int a = 0; a < 2; ++a)
#pragma unroll
            for (int b = 0; b < 2; ++b)
#pragma unroll
                for (int m = 0; m < 4; ++m)
#pragma unroll
                    for (int n = 0; n < 2; ++n) acc[a][b][m][n] = (f32x4){0.f, 0.f, 0.f, 0.f};
        cur = nxt; cA = nA; cB = nB; ++ui;
        if constexpr (ALIGN_EPI) { if (wr == 1) PG8_BAR; }
    }
    PG8_WAIT_V(0);
    if constexpr (!ALIGN_EPI) { if (wr == 0) PG8_BAR; }
    PG8_BAR;
    if constexpr (Epi::AFTER_DRAIN) { E.fused(acc, cur, wr, wc, fr, fq, lds, wid, lane); S.done(cur); }
#undef PG8_SA
#undef PG8_SB
#undef PG8_STAGE
#undef PG8_LDA
#undef PG8_LDB
#undef PG8_MMA
#undef PG8_WAIT_V
#undef PG8_WAIT_L
#undef PG8_BAR
#undef PG8_SCHED
}
}

#ifndef PG8_SP2
#define PG8_SP2 true
#endif
#ifndef PG8_ALIGN
#define PG8_ALIGN true
#endif
#define DI __device__ __forceinline__
#define LAS __attribute__((address_space(3)))
typedef LAS unsigned char* lds_t;
typedef unsigned short bf16_t;
typedef short bf16x8 __attribute__((ext_vector_type(8)));
typedef short s16x4 __attribute__((ext_vector_type(4)));
typedef short v4i16_t __attribute__((ext_vector_type(4)));
typedef float f32x4 __attribute__((ext_vector_type(4)));
typedef float f32x2 __attribute__((ext_vector_type(2)));
typedef unsigned u32x4 __attribute__((ext_vector_type(4)));
typedef unsigned u32x2 __attribute__((ext_vector_type(2)));

constexpr int T_ = 32768, L_ = 4096, D_ = 1024, IN_ = 10768, FF_ = 2816;
constexpr size_t MiB = 1u << 20;
constexpr size_t WS_WIN = 0, WS_WPA = 22 * MiB, WS_WPB = 24 * MiB, WS_WOUT = 25 * MiB, WS_WGU = 27 * MiB, WS_WDN = 38 * MiB;
constexpr size_t WS_ROPE = 44 * MiB, WS_BG = 45 * MiB, WS_LSE = 48 * MiB, WS_GL = 50 * MiB;
constexpr size_t U_ = 64 * MiB;
constexpr size_t S1 = 1 * U_, S2 = 2 * U_, S3 = 3 * U_, S4 = 4 * U_, S5 = 5 * U_, S6 = 6 * U_, S7 = 7 * U_;
constexpr size_t WS_AQKV = S1;
constexpr size_t WS_OG = S1 + 9 * U_ / 2;
constexpr size_t WS_DQKV = S1;
constexpr size_t WS_QD = S4, WS_KDT = S5, WS_U = S6, WS_W = S7;
constexpr size_t WS_ORAW = S1;
constexpr size_t WS_ZG = S4;
constexpr size_t WS_OA = S7;
constexpr size_t WS_PART = S1;
constexpr size_t WS_MERGED = S3;
constexpr size_t WS_X1 = S4;
constexpr size_t WS_H2 = S6;
constexpr size_t WS_ACT = S1;
constexpr size_t DO_H1 = 0, DO_OB = U_, DO_QK = U_ + U_ / 2;
constexpr int LDS_BYTES = 159744;

struct Params {
  const float *x, *norm1_w, *w_in, *conv_w, *a_log, *dt_bias, *dn_norm_w, *w_proj_a, *w_proj_b, *w_out, *norm2_w, *w_gate_up, *w_down, *final_norm_w;
  float* out; unsigned char* ws;
};

DI int lane_id() { int l; asm volatile("v_mbcnt_lo_u32_b32 %0, -1, 0\n\tv_mbcnt_hi_u32_b32 %0, -1, %0" : "=v"(l)); return l; }
#define TIDS() const int wave = wv, lane = lane_id(), tid = (wv << 6) | lane; (void)lane; (void)wave; (void)tid
typedef __bf16 bf16v2_t __attribute__((ext_vector_type(2)));
DI unsigned pk2(float lo, float hi) { const f32x2 v = {lo, hi}; return __builtin_bit_cast(unsigned, __builtin_convertvector(v, bf16v2_t)); }
DI unsigned f2bf(float f) { return pk2(f, 0.f) & 0xffffu; }
DI float bf2f(unsigned h) { return __builtin_bit_cast(float, h << 16); }
DI float bflo(unsigned w) { return __builtin_bit_cast(float, w << 16); }
DI float bfhi(unsigned w) { return __builtin_bit_cast(float, w & 0xffff0000u); }
#define BPERM(srcl, v) __shfl((v), (srcl))
template <int M> DI float shx(float v, int lane) { return BPERM(lane ^ M, v); }
DI float wave_sum(float v, int lane) { v += shx<1>(v, lane); v += shx<2>(v, lane); v += shx<4>(v, lane); v += shx<8>(v, lane); v += shx<16>(v, lane); v += shx<32>(v, lane); return v; }
DI float sum16(float v, int lane) { v += shx<1>(v, lane); v += shx<2>(v, lane); v += shx<4>(v, lane); v += shx<8>(v, lane); return v; }
DI float max16(float v, int lane) { v = fmaxf(v, shx<1>(v, lane)); v = fmaxf(v, shx<2>(v, lane)); v = fmaxf(v, shx<4>(v, lane)); v = fmaxf(v, shx<8>(v, lane)); return v; }
DI float sigmoidf_(float x) { return __builtin_amdgcn_rcpf(1.f + __expf(-x)); }
DI float siluf_(float x) { return x * __builtin_amdgcn_rcpf(1.f + __expf(-x)); }
DI s16x4 lds_tr(lds_t p) { return __builtin_bit_cast(s16x4, __builtin_amdgcn_ds_read_tr16_b64_v4i16((LAS v4i16_t*)p)); }
DI bf16x8 lds_ld16(lds_t p) { return *(LAS bf16x8*)p; }
#define MFMA16(a, b, c) __builtin_amdgcn_mfma_f32_16x16x32_bf16((a), (b), (c), 0, 0, 0)

using pg8::Unit;
DI unsigned cvt_pk_bf16(float lo, float hi) { return pk2(lo, hi); }
DI u32x4 pack8(f32x4 v0, f32x4 v1) { u32x4 w; w.x = cvt_pk_bf16(v0[0], v0[1]); w.y = cvt_pk_bf16(v0[2], v0[3]); w.z = cvt_pk_bf16(v1[0], v1[1]); w.w = cvt_pk_bf16(v1[2], v1[3]); return w; }

struct EpiRope {
  static constexpr bool PERM = true, AFTER_DRAIN = false;
  bf16_t* O; const float* rope;
  DI void operator()(const f32x4 (&acc)[2][2][4][2], const Unit& u, int wr, int wc, int fr, int fq) const {
    const int row0 = u.pm * 256 + wr * 64 + fr;
#pragma unroll
    for (int bj = 0; bj < 2; ++bj) {
      const int colb = u.pn * 256 + 128 * bj; const bool dorope = (colb < 3072) && (wc == 0);
#pragma unroll
      for (int ai = 0; ai < 2; ++ai)
#pragma unroll
        for (int m = 0; m < 4; ++m) {
          const int row = row0 + ai * 128 + m * 16; f32x4 v0 = acc[ai][bj][m][0], v1 = acc[ai][bj][m][1];
          if (dorope) {
            const int pos = row & (L_ - 1); const float* rp = rope + ((size_t)pos * 16 + 8 * (fq & 1)) * 2;
            f32x4 p0, p1;
#pragma unroll
            for (int e = 0; e < 4; ++e) { p0[e] = BPERM((fq * 16 + fr) ^ 32, v0[e]); p1[e] = BPERM((fq * 16 + fr) ^ 32, v1[e]); }
            const f32x4 c0 = *(const f32x4*)(rp), c1 = *(const f32x4*)(rp + 4), c2 = *(const f32x4*)(rp + 8), c3 = *(const f32x4*)(rp + 12);
            const float cs[8] = {c0[0], c0[2], c1[0], c1[2], c2[0], c2[2], c3[0], c3[2]}, sn[8] = {c0[1], c0[3], c1[1], c1[3], c2[1], c2[3], c3[1], c3[3]};
            const float sg = (fq < 2) ? -1.f : 1.f;
#pragma unroll
            for (int e = 0; e < 4; ++e) { v0[e] = v0[e] * cs[e] + sg * p0[e] * sn[e]; v1[e] = v1[e] * cs[4 + e] + sg * p1[e] * sn[4 + e]; }
          }
          *(u32x4*)(O + (size_t)row * 4608 + colb + wc * 32 + 8 * fq) = pack8(v0, v1);
        }
    }
  }
};
struct EpiDn {
  static constexpr bool PERM = true, AFTER_DRAIN = false;
  bf16_t* O; float* BG;
  DI void operator()(const f32x4 (&acc)[2][2][4][2], const Unit& u, int wr, int wc, int fr, int fq) const {
    const int row0 = u.pm * 256 + wr * 64 + fr;
    if (u.pn < 12) {
#pragma unroll
      for (int ai = 0; ai < 2; ++ai)
#pragma unroll
        for (int m = 0; m < 4; ++m)
#pragma unroll
          for (int bj = 0; bj < 2; ++bj)
            *(u32x4*)(O + (size_t)(row0 + ai * 128 + m * 16) * 3072 + u.pn * 256 + bj * 128 + wc * 32 + 8 * fq) = pack8(acc[ai][bj][m][0], acc[ai][bj][m][1]);
    } else if (wc == 0 && fq < 2) {
#pragma unroll
      for (int ai = 0; ai < 2; ++ai)
#pragma unroll
        for (int m = 0; m < 4; ++m) { float* o = BG + (size_t)(row0 + ai * 128 + m * 16) * 16 + 8 * fq; *(f32x4*)o = acc[ai][0][m][0]; *(f32x4*)(o + 4) = acc[ai][0][m][1]; }
    }
  }
};
struct EpiZG {
  static constexpr bool PERM = true, AFTER_DRAIN = false;
  bf16_t* O;
  DI void operator()(const f32x4 (&acc)[2][2][4][2], const Unit& u, int wr, int wc, int fr, int fq) const {
    const int row0 = u.pm * 256 + wr * 64 + fr; const bool sg = u.pn >= 4;
#pragma unroll
    for (int ai = 0; ai < 2; ++ai)
#pragma unroll
      for (int m = 0; m < 4; ++m)
#pragma unroll
        for (int bj = 0; bj < 2; ++bj) { f32x4 v0 = acc[ai][bj][m][0], v1 = acc[ai][bj][m][1];
          if (sg) {
#pragma unroll
            for (int e = 0; e < 4; ++e) { v0[e] = sigmoidf_(v0[e]); v1[e] = sigmoidf_(v1[e]); } }
          *(u32x4*)(O + (size_t)(row0 + ai * 128 + m * 16) * 3072 + u.pn * 256 + bj * 128 + wc * 32 + 8 * fq) = pack8(v0, v1); }
  }
};
struct EpiYa {
  static constexpr bool PERM = true, AFTER_DRAIN = false;
  bf16_t* PART; const bf16_t* ZG;
  DI void operator()(const f32x4 (&acc)[2][2][4][2], const Unit& u, int wr, int wc, int fr, int fq) const {
    const int row0 = u.pm * 256 + wr * 64 + fr;
#pragma unroll
    for (int ai = 0; ai < 2; ++ai)
#pragma unroll
      for (int m = 0; m < 4; ++m)
#pragma unroll
        for (int bj = 0; bj < 2; ++bj) { const int row = row0 + ai * 128 + m * 16, col = u.pn * 256 + bj * 128 + wc * 32 + 8 * fq;
          const u32x4 g = *(const u32x4*)(ZG + (size_t)row * 3072 + 1024 + col);
          f32x4 v0 = acc[ai][bj][m][0], v1 = acc[ai][bj][m][1];
          v0[0] *= bflo(g.x); v0[1] *= bfhi(g.x); v0[2] *= bflo(g.y); v0[3] *= bfhi(g.y); v1[0] *= bflo(g.z); v1[1] *= bfhi(g.z); v1[2] *= bflo(g.w); v1[3] *= bfhi(g.w);
          *(u32x4*)(PART + (size_t)row * 1024 + col) = pack8(v0, v1); }
  }
};
struct EpiYb {
  static constexpr bool PERM = true, AFTER_DRAIN = false;
  const bf16_t* PART; const bf16_t* ZG; bf16_t* MG;
  DI void operator()(const f32x4 (&acc)[2][2][4][2], const Unit& u, int wr, int wc, int fr, int fq) const {
    const int row0 = u.pm * 256 + wr * 64 + fr;
#pragma unroll
    for (int ai = 0; ai < 2; ++ai)
#pragma unroll
      for (int m = 0; m < 4; ++m)
#pragma unroll
        for (int bj = 0; bj < 2; ++bj) { const int row = row0 + ai * 128 + m * 16, col = u.pn * 256 + bj * 128 + wc * 32 + 8 * fq;
          const u32x4 g = *(const u32x4*)(ZG + (size_t)row * 3072 + 2048 + col);
          const u32x4 pq = *(const u32x4*)(PART + (size_t)row * 1024 + col); f32x4 v0 = {bflo(pq.x), bfhi(pq.x), bflo(pq.y), bfhi(pq.y)}, v1 = {bflo(pq.z), bfhi(pq.z), bflo(pq.w), bfhi(pq.w)};
          const f32x4 a0 = acc[ai][bj][m][0], a1 = acc[ai][bj][m][1];
          v0[0] += a0[0] * bflo(g.x); v0[1] += a0[1] * bfhi(g.x); v0[2] += a0[2] * bflo(g.y); v0[3] += a0[3] * bfhi(g.y);
          v1[0] += a1[0] * bflo(g.z); v1[1] += a1[1] * bfhi(g.z); v1[2] += a1[2] * bflo(g.w); v1[3] += a1[3] * bfhi(g.w);
          *(u32x4*)(MG + (size_t)row * 1024 + col) = pack8(v0, v1); }
  }
};
struct EpiRes {
  static constexpr bool PERM = true, AFTER_DRAIN = false;
  const float* RES; float* OUT;
  DI void operator()(const f32x4 (&acc)[2][2][4][2], const Unit& u, int wr, int wc, int fr, int fq) const {
    const int row0 = u.pm * 256 + wr * 64 + fr;
#pragma unroll
    for (int ai = 0; ai < 2; ++ai)
#pragma unroll
      for (int m = 0; m < 4; ++m)
#pragma unroll
        for (int bj = 0; bj < 2; ++bj) { const size_t off = (size_t)(row0 + ai * 128 + m * 16) * 1024 + u.pn * 256 + bj * 128 + wc * 32 + 8 * fq;
          const f32x4 r0 = *(const f32x4*)(RES + off), r1 = *(const f32x4*)(RES + off + 4);
          *(f32x4*)(OUT + off) = r0 + acc[ai][bj][m][0]; *(f32x4*)(OUT + off + 4) = r1 + acc[ai][bj][m][1]; }
  }
};
struct EpiResToB {
  static constexpr bool PERM = true, AFTER_DRAIN = false;
  const float* RES; bf16_t* OUT;
  DI void operator()(const f32x4 (&acc)[2][2][4][2], const Unit& u, int wr, int wc, int fr, int fq) const {
    const int row0 = u.pm * 256 + wr * 64 + fr;
#pragma unroll
    for (int ai = 0; ai < 2; ++ai)
#pragma unroll
      for (int m = 0; m < 4; ++m)
#pragma unroll
        for (int bj = 0; bj < 2; ++bj) { const size_t off = (size_t)(row0 + ai * 128 + m * 16) * 1024 + u.pn * 256 + bj * 128 + wc * 32 + 8 * fq;
          const f32x4 r0 = *(const f32x4*)(RES + off), r1 = *(const f32x4*)(RES + off + 4);
          *(u32x4*)(OUT + off) = pack8(r0 + acc[ai][bj][m][0], r1 + acc[ai][bj][m][1]); }
  }
};
struct EpiResFromB {
  static constexpr bool PERM = true, AFTER_DRAIN = false;
  const bf16_t* RES; float* OUT;
  DI void operator()(const f32x4 (&acc)[2][2][4][2], const Unit& u, int wr, int wc, int fr, int fq) const {
    const int row0 = u.pm * 256 + wr * 64 + fr;
#pragma unroll
    for (int ai = 0; ai < 2; ++ai)
#pragma unroll
      for (int m = 0; m < 4; ++m)
#pragma unroll
        for (int bj = 0; bj < 2; ++bj) { const size_t off = (size_t)(row0 + ai * 128 + m * 16) * 1024 + u.pn * 256 + bj * 128 + wc * 32 + 8 * fq;
          const u32x4 q = *(const u32x4*)(RES + off);
          const f32x4 r0 = {bflo(q.x), bfhi(q.x), bflo(q.y), bfhi(q.y)}, r1 = {bflo(q.z), bfhi(q.z), bflo(q.w), bfhi(q.w)};
          *(f32x4*)(OUT + off) = r0 + acc[ai][bj][m][0]; *(f32x4*)(OUT + off + 4) = r1 + acc[ai][bj][m][1]; }
  }
};
struct EpiResBB {
  static constexpr bool PERM = true, AFTER_DRAIN = false;
  const bf16_t* RES; bf16_t* OUT;
  DI void operator()(const f32x4 (&acc)[2][2][4][2], const Unit& u, int wr, int wc, int fr, int fq) const {
    const int row0 = u.pm * 256 + wr * 64 + fr;
#pragma unroll
    for (int ai = 0; ai < 2; ++ai)
#pragma unroll
      for (int m = 0; m < 4; ++m)
#pragma unroll
        for (int bj = 0; bj < 2; ++bj) { const size_t off = (size_t)(row0 + ai * 128 + m * 16) * 1024 + u.pn * 256 + bj * 128 + wc * 32 + 8 * fq;
          const u32x4 q = *(const u32x4*)(RES + off);
          const f32x4 r0 = {bflo(q.x), bfhi(q.x), bflo(q.y), bfhi(q.y)}, r1 = {bflo(q.z), bfhi(q.z), bflo(q.w), bfhi(q.w)};
          *(u32x4*)(OUT + off) = pack8(r0 + acc[ai][bj][m][0], r1 + acc[ai][bj][m][1]); }
  }
};
struct EpiSwiglu {
  static constexpr bool PERM = true, AFTER_DRAIN = false;
  bf16_t* ACT;
  DI void operator()(const f32x4 (&acc)[2][2][4][2], const Unit& u, int wr, int wc, int fr, int fq) const {
    const int row0 = u.pm * 256 + wr * 64 + fr;
#pragma unroll
    for (int ai = 0; ai < 2; ++ai)
#pragma unroll
      for (int m = 0; m < 4; ++m) { f32x4 v0, v1;
#pragma unroll
        for (int e = 0; e < 4; ++e) { v0[e] = siluf_(acc[ai][0][m][0][e]) * acc[ai][1][m][0][e]; v1[e] = siluf_(acc[ai][0][m][1][e]) * acc[ai][1][m][1][e]; }
        *(u32x4*)(ACT + (size_t)(row0 + ai * 128 + m * 16) * FF_ + u.pn * 128 + wc * 32 + 8 * fq) = pack8(v0, v1); }
  }
};
DI void tr_item(const float* W, int ldw, int K, bf16_t* WT, LAS float* scr, int k0, int lane) {
  float tv[32];
#pragma unroll
  for (int i = 0; i < 32; ++i) tv[i] = W[(size_t)(k0 + 2 * i + (lane >> 5)) * ldw + (lane & 31)];
#pragma unroll
  for (int i = 0; i < 32; ++i) scr[(2 * i + (lane >> 5)) * 33 + (lane & 31)] = tv[i];
  asm volatile("s_waitcnt lgkmcnt(0)" ::: "memory");
  const int c = lane & 7;
#pragma unroll
  for (int j = 0; j < 4; ++j) { const int n = (lane >> 3) + 8 * j; const LAS float* s = scr + (8 * c) * 33 + n;
    u32x4 o; o.x = pk2(s[0 * 33], s[1 * 33]); o.y = pk2(s[2 * 33], s[3 * 33]); o.z = pk2(s[4 * 33], s[5 * 33]); o.w = pk2(s[6 * 33], s[7 * 33]);
    *(u32x4*)(WT + (size_t)n * K + k0 + 8 * c) = o; }
  asm volatile("s_waitcnt lgkmcnt(0)" ::: "memory");
}
DI void rms_row_bf16(const float* xrow, const float* w, bf16_t* orow, int lane) {
  const f32x4* xr = (const f32x4*)xrow + lane; const f32x4* wr = (const f32x4*)w + lane;
  f32x4 v[4]; float s = 0.f;
#pragma unroll
  for (int j = 0; j < 4; ++j) { v[j] = xr[64 * j]; s += (v[j].x * v[j].x + v[j].y * v[j].y) + (v[j].z * v[j].z + v[j].w * v[j].w); }
  const float r = 1.f / sqrtf(wave_sum(s, lane) * (1.f / 1024.f) + 1e-6f);
  unsigned long long* o8 = (unsigned long long*)orow + lane;
#pragma unroll
  for (int j = 0; j < 4; ++j) { const f32x4 g = wr[64 * j];
    o8[64 * j] = (unsigned long long)pk2(v[j].x * r * g.x, v[j].y * r * g.y) | ((unsigned long long)pk2(v[j].z * r * g.z, v[j].w * r * g.w) << 32); }
}
DI void rms_row2_bf16(const float* x0, const float* x1, const float* w, bf16_t* o0, bf16_t* o1, int lane) {
  const f32x4* xa = (const f32x4*)x0 + lane; const f32x4* xb = (const f32x4*)x1 + lane; const f32x4* wr = (const f32x4*)w + lane;
  f32x4 va[4], vb[4]; float sa = 0.f, sb = 0.f;
#pragma unroll
  for (int j = 0; j < 4; ++j) { va[j] = xa[64 * j]; vb[j] = xb[64 * j]; }
#pragma unroll
  for (int j = 0; j < 4; ++j) { sa += (va[j].x * va[j].x + va[j].y * va[j].y) + (va[j].z * va[j].z + va[j].w * va[j].w); sb += (vb[j].x * vb[j].x + vb[j].y * vb[j].y) + (vb[j].z * vb[j].z + vb[j].w * vb[j].w); }
  const float ra = 1.f / sqrtf(wave_sum(sa, lane) * (1.f / 1024.f) + 1e-6f), rb = 1.f / sqrtf(wave_sum(sb, lane) * (1.f / 1024.f) + 1e-6f);
  unsigned long long* pa = (unsigned long long*)o0 + lane; unsigned long long* pb = (unsigned long long*)o1 + lane;
#pragma unroll
  for (int j = 0; j < 4; ++j) { const f32x4 g = wr[64 * j];
    pa[64 * j] = (unsigned long long)pk2(va[j].x * ra * g.x, va[j].y * ra * g.y) | ((unsigned long long)pk2(va[j].z * ra * g.z, va[j].w * ra * g.w) << 32);
    pb[64 * j] = (unsigned long long)pk2(vb[j].x * rb * g.x, vb[j].y * rb * g.y) | ((unsigned long long)pk2(vb[j].z * rb * g.z, vb[j].w * rb * g.w) << 32); }
}
DI void p0_prologue(const Params& p, lds_t lds, int wv) { TIDS();
  unsigned char* ws = p.ws;
  LAS float* scr = (LAS float*)(lds + wave * 16384);
  const int gw = blockIdx.x * 8 + wave, NGW = gridDim.x * 8;
  bf16_t* WIN = (bf16_t*)(ws + WS_WIN);
  constexpr int I0 = 16 * 144, I1 = 16 * 96, I2 = 16, I3 = 16 * 32, I4 = 16 * 64, I5 = 16 * 32, I6 = 8 * 32, I7 = 16 * 32, I8 = 16 * 176, I9 = 44 * 32;
  constexpr int NITEMS = I0 + I1 + I2 + I3 + I4 + I5 + I6 + I7 + I8 + I9;
  for (int it = gw; it < NITEMS; it += NGW) {
    int r = it;
    if (r < I0) { const int kb = r / 144, nb = r % 144; tr_item(p.w_in + 4112 + 32 * nb, IN_, 1024, WIN + (size_t)(0 + 32 * nb) * 1024, scr, 64 * kb, lane); continue; } r -= I0;
    if (r < I1) { const int kb = r / 96, nb = r % 96; tr_item(p.w_in + 0 + 32 * nb, IN_, 1024, WIN + (size_t)(4608 + 32 * nb) * 1024, scr, 64 * kb, lane); continue; } r -= I1;
    if (r < I2) { const int kb = r; tr_item(p.w_in + 4096, IN_, 1024, WIN + (size_t)7680 * 1024, scr, 64 * kb, lane); continue; } r -= I2;
    if (r < I3) { const int kb = r / 32, nb = r % 32; tr_item(p.w_in + 3072 + 32 * nb, IN_, 1024, WIN + (size_t)(7936 + 32 * nb) * 1024, scr, 64 * kb, lane); continue; } r -= I3;
    if (r < I4) { const int kb = r / 64, nb = r % 64; tr_item(p.w_in + 8720 + 32 * nb, IN_, 1024, WIN + (size_t)(8960 + 32 * nb) * 1024, scr, 64 * kb, lane); continue; } r -= I4;
    if (r < I5) { const int kb = r / 32, nb = r % 32; tr_item(p.w_proj_a + 32 * nb, 1024, 1024, (bf16_t*)(ws + WS_WPA) + (size_t)(32 * nb) * 1024, scr, 64 * kb, lane); continue; } r -= I5;
    if (r < I6) { const int kb = r / 32, nb = r % 32; tr_item(p.w_proj_b + 32 * nb, 1024, 512, (bf16_t*)(ws + WS_WPB) + (size_t)(32 * nb) * 512, scr, 64 * kb, lane); continue; } r -= I6;
    if (r < I7) { const int kb = r / 32, nb = r % 32; tr_item(p.w_out + 32 * nb, 1024, 1024, (bf16_t*)(ws + WS_WOUT) + (size_t)(32 * nb) * 1024, scr, 64 * kb, lane); continue; } r -= I7;
    if (r < I8) { const int kb = r / 176, nb = r % 176; const int pn = nb >> 3, bj = (nb >> 2) & 1, r0 = (nb & 3) * 32;
      tr_item(p.w_gate_up + bj * FF_ + 128 * pn + r0, 2 * FF_, 1024, (bf16_t*)(ws + WS_WGU) + (size_t)(32 * nb) * 1024, scr, 64 * kb, lane); continue; } r -= I8;
    { const int kb = r / 32, nb = r % 32; tr_item(p.w_down + 32 * nb, 1024, FF_, (bf16_t*)(ws + WS_WDN) + (size_t)(32 * nb) * FF_, scr, 64 * kb, lane); }
  }
  { float* rope = (float*)(ws + WS_ROPE);
    for (int i = blockIdx.x * 512 + tid; i < L_ * 16; i += gridDim.x * 512) { const int pos = i >> 4, f = i & 15;
      const float invf = powf(500000.0f, -(float)f * (1.0f / 16.0f)); const float ang = (float)pos * invf; float sn, cs; sincosf(ang, &sn, &cs);
      rope[2 * i] = cs; rope[2 * i + 1] = sn; } }
  bf16_t* H1 = (bf16_t*)((unsigned char*)p.out + DO_H1);
  for (int m = gw; m < T_; m += 2 * NGW) { const int m2 = (m + NGW < T_) ? m + NGW : m; rms_row2_bf16(p.x + (size_t)m * D_, p.x + (size_t)m2 * D_, p.norm1_w, H1 + (size_t)m * D_, H1 + (size_t)m2 * D_, lane); }
}

constexpr int AT_RS = 272;
constexpr int AT_KV_BYTES = 272 * AT_RS;
constexpr int AT_PS = 336;
constexpr int AT_P_OFF = AT_KV_BYTES, AT_P_WAVE = 16 * AT_PS;
DI void attn_unit_coords(int unit, int& g, int& dsh, int& hs, int& b, int& r, int& nb, int& head) {
  g = unit >> 10; const int rem = unit & 1023; dsh = 2 * g; const int nbk = 32 >> dsh;
  nb = rem & (nbk - 1); const int chain = rem >> (5 - dsh); hs = chain & 3; const int br = chain >> 2; r = br & ((1 << dsh) - 1); b = br >> dsh; head = g * 4 + hs;
}
DI void attn_load(u32x4 (&v)[8], const bf16_t* base  , int b, int r, int nb, int dsh, int tid) {
#pragma unroll
  for (int pss = 0; pss < 8; ++pss) { const int idx = tid + 512 * pss, key = idx >> 4, ch = idx & 15;
    const int mi = (nb - 1) * 128 + key; v[pss] = (u32x4){0u, 0u, 0u, 0u};
    if (mi >= 0) { const size_t row = (size_t)b * L_ + ((size_t)mi << dsh) + r; v[pss] = *(const u32x4*)(base + row * 4608 + ch * 8); } }
}
DI void attn_store(lds_t buf, const u32x4 (&v)[8], int tid) {
#pragma unroll
  for (int pss = 0; pss < 8; ++pss) { const int idx = tid + 512 * pss, key = idx >> 4, ch = idx & 15; *(LAS u32x4*)(buf + key * AT_RS + ch * 16) = v[pss]; }
  if (tid < 256) { const int key = 256 + (tid >> 4), ch = tid & 15; *(LAS u32x4*)(buf + key * AT_RS + ch * 16) = (u32x4){0u, 0u, 0u, 0u}; }
}
#define LDS_BAR() do { asm volatile("s_waitcnt lgkmcnt(0)" ::: "memory"); __builtin_amdgcn_s_barrier(); asm volatile("" ::: "memory"); } while (0)
DI void attn_phase(const Params& p, lds_t lds, int wv) { TIDS();
  const bf16_t* AQKV = (const bf16_t*)(p.ws + WS_AQKV); bf16_t* OG = (bf16_t*)(p.ws + WS_OG); float* LSE = (float*)(p.ws + WS_LSE);
  const int fr = lane & 15, fq = lane >> 4;
  lds_t Pw = lds + AT_P_OFF + wave * AT_P_WAVE;
  u32x4 kreg[8], vreg[8]; bf16x8 qf[4];
  int g, dsh, hs, b, r, nb, head;
  const int per = (3072 + gridDim.x - 1) / gridDim.x, u0 = blockIdx.x * per, u1 = (u0 + per < 3072) ? u0 + per : 3072;
  if (u0 < 3072) {
    attn_unit_coords(u0, g, dsh, hs, b, r, nb, head);
    attn_load(kreg, AQKV + 1536 + head * 128, b, r, nb, dsh, tid);
    const size_t qrow = (size_t)b * L_ + (((size_t)(nb * 128 + 16 * wave + fr)) << dsh) + r; const bf16_t* qp = AQKV + qrow * 4608 + head * 128 + fq * 8;
#pragma unroll
    for (int ks = 0; ks < 4; ++ks) qf[ks] = *(const bf16x8*)(qp + ks * 32);
  }
  for (int unit = u0; unit < u1; ++unit) {
    attn_unit_coords(unit, g, dsh, hs, b, r, nb, head);
    LDS_BAR();
    attn_store(lds, kreg, tid);
    attn_load(vreg, AQKV + 3072 + head * 128, b, r, nb, dsh, tid);
    bf16x8 qc[4];
#pragma unroll
    for (int ks = 0; ks < 4; ++ks) qc[ks] = qf[ks];
    LDS_BAR();
    f32x4 sc[9];
#pragma unroll
    for (int ct = 0; ct < 9; ++ct) { sc[ct] = (f32x4){0.f, 0.f, 0.f, 0.f};
      lds_t kp = lds + (16 * (wave + ct) + fr) * AT_RS + fq * 16;
#pragma unroll
      for (int ks = 0; ks < 4; ++ks) sc[ct] = MFMA16(qc[ks], lds_ld16(kp + ks * 64), sc[ct]); }
    const float SCL = 0.08838834764831845f * 1.4426950408889634f;
    float mx[4] = {-3.0e38f, -3.0e38f, -3.0e38f, -3.0e38f};
#pragma unroll
    for (int ct = 0; ct < 9; ++ct) { const bool tile_ok = (nb > 0) || (wave + ct >= 8);
#pragma unroll
      for (int j = 0; j < 4; ++j) { bool ok = tile_ok;
        if (ct == 0) ok = ok && (fr >= 4 * fq + j);
        if (ct == 8) ok = ok && (fr <= 4 * fq + j);
        const float s = ok ? sc[ct][j] : -3.0e38f; sc[ct][j] = s; mx[j] = fmaxf(mx[j], s); } }
#pragma unroll
    for (int j = 0; j < 4; ++j) mx[j] = max16(mx[j], lane) * SCL;
    float den[4] = {0.f, 0.f, 0.f, 0.f};
#pragma unroll
    for (int ct = 0; ct < 9; ++ct)
#pragma unroll
      for (int j = 0; j < 4; ++j) { const float e = __builtin_amdgcn_exp2f(fmaf(sc[ct][j], SCL, -mx[j])); den[j] += e;
        *(LAS bf16_t*)(Pw + (4 * fq + j) * AT_PS + (16 * ct + fr) * 2) = (bf16_t)f2bf(e); }
#pragma unroll
    for (int j = 0; j < 4; ++j) { *(LAS bf16_t*)(Pw + (4 * fq + j) * AT_PS + (144 + fr) * 2) = 0; den[j] = sum16(den[j], lane); }
    LDS_BAR();
    attn_store(lds, vreg, tid);
    { const int nu = unit + 1;
      if (nu < u1) { int g2, dsh2, hs2, b2, r2, nb2, head2; attn_unit_coords(nu, g2, dsh2, hs2, b2, r2, nb2, head2);
        attn_load(kreg, AQKV + 1536 + head2 * 128, b2, r2, nb2, dsh2, tid);
        const size_t qrow = (size_t)b2 * L_ + (((size_t)(nb2 * 128 + 16 * wave + fr)) << dsh2) + r2; const bf16_t* qp = AQKV + qrow * 4608 + head2 * 128 + fq * 8;
#pragma unroll
        for (int ks = 0; ks < 4; ++ks) qf[ks] = *(const bf16x8*)(qp + ks * 32); } }
    LDS_BAR();
    f32x4 oa[8];
#pragma unroll
    for (int dt = 0; dt < 8; ++dt) oa[dt] = (f32x4){0.f, 0.f, 0.f, 0.f};
#pragma unroll
    for (int ks = 0; ks < 5; ++ks) { const bf16x8 a = lds_ld16(Pw + fr * AT_PS + (ks * 32 + fq * 8) * 2);
      lds_t vp = lds + (16 * wave + ks * 32 + fq * 8 + (fr >> 2)) * AT_RS + (fr & 3) * 8;
#pragma unroll
      for (int dt = 0; dt < 8; ++dt) { const s16x4 lo = lds_tr(vp + dt * 32), hi = lds_tr(vp + 4 * AT_RS + dt * 32);
        const bf16x8 bb = __builtin_shufflevector(lo, hi, 0, 1, 2, 3, 4, 5, 6, 7); oa[dt] = MFMA16(a, bb, oa[dt]); } }
#pragma unroll
    for (int j = 0; j < 4; ++j) { const int qi = 16 * wave + 4 * fq + j; const size_t row = (size_t)b * L_ + (((size_t)(nb * 128 + qi)) << dsh) + r;
      const float inv = 1.f / den[j]; bf16_t* op = OG + ((size_t)g * T_ + row) * 512 + hs * 128 + fr;
#pragma unroll
      for (int dt = 0; dt < 8; ++dt) op[dt * 16] = (bf16_t)f2bf(oa[dt][j] * inv);
      if (fr == 0) LSE[((size_t)g * T_ + row) * 4 + hs] = (mx[j] + log2f(den[j])) * 0.6931471805599453f; }
  }
}
DI void combine_phase(const Params& p, int wv) { TIDS();
  const bf16_t* OG = (const bf16_t*)(p.ws + WS_OG); const float* LSE = (const float*)(p.ws + WS_LSE); bf16_t* OB = (bf16_t*)((unsigned char*)p.out + DO_OB);
  for (size_t it = (size_t)blockIdx.x * 512 + tid; it < (size_t)T_ * 64; it += (size_t)gridDim.x * 512) {
    const size_t row = it >> 6; const int c = (int)(it & 63), hs = c >> 4;
    const float l0 = LSE[row * 4 + hs], l1 = LSE[((size_t)T_ + row) * 4 + hs], l2 = LSE[((size_t)2 * T_ + row) * 4 + hs];
    const float mx = fmaxf(l0, fmaxf(l1, l2)); float e0 = __expf(l0 - mx), e1 = __expf(l1 - mx), e2 = __expf(l2 - mx); const float inv = 1.f / (e0 + e1 + e2); e0 *= inv; e1 *= inv; e2 *= inv;
    const u32x4 a = *(const u32x4*)(OG + row * 512 + c * 8), bq = *(const u32x4*)(OG + ((size_t)T_ + row) * 512 + c * 8), cq = *(const u32x4*)(OG + ((size_t)2 * T_ + row) * 512 + c * 8);
    u32x4 o;
    o.x = pk2(e0 * bflo(a.x) + e1 * bflo(bq.x) + e2 * bflo(cq.x), e0 * bfhi(a.x) + e1 * bfhi(bq.x) + e2 * bfhi(cq.x));
    o.y = pk2(e0 * bflo(a.y) + e1 * bflo(bq.y) + e2 * bflo(cq.y), e0 * bfhi(a.y) + e1 * bfhi(bq.y) + e2 * bfhi(cq.y));
    o.z = pk2(e0 * bflo(a.z) + e1 * bflo(bq.z) + e2 * bflo(cq.z), e0 * bfhi(a.z) + e1 * bfhi(bq.z) + e2 * bfhi(cq.z));
    o.w = pk2(e0 * bflo(a.w) + e1 * bflo(bq.w) + e2 * bflo(cq.w), e0 * bfhi(a.w) + e1 * bfhi(bq.w) + e2 * bfhi(cq.w));
    *(u32x4*)(OB + row * 512 + c * 8) = o;
  }
}

DI void bg_phase(const Params& p, int wv) { TIDS();
  const bf16_t* H1 = (const bf16_t*)((const unsigned char*)p.out + DO_H1); const bf16_t* WB = (const bf16_t*)(p.ws + WS_WIN) + (size_t)7680 * 1024; float* BG = (float*)(p.ws + WS_BG);
  const int fr = lane & 15, fq = lane >> 4;
  for (int tile = blockIdx.x * 8 + wave; tile < T_ / 16; tile += gridDim.x * 8) {
    const bf16_t* ap = H1 + ((size_t)tile * 16 + fr) * 1024 + fq * 8; const bf16_t* bp = WB + (size_t)fr * 1024 + fq * 8;
    f32x4 acc0 = {0.f, 0.f, 0.f, 0.f}, acc1 = {0.f, 0.f, 0.f, 0.f};
#pragma unroll 8
    for (int ks = 0; ks < 32; ks += 2) { acc0 = MFMA16(*(const bf16x8*)(ap + ks * 32), *(const bf16x8*)(bp + ks * 32), acc0); acc1 = MFMA16(*(const bf16x8*)(ap + ks * 32 + 32), *(const bf16x8*)(bp + ks * 32 + 32), acc1); }
#pragma unroll
    for (int j = 0; j < 4; ++j) BG[((size_t)tile * 16 + 4 * fq + j) * 16 + fr] = acc0[j] + acc1[j];
  }
}
template <int NL> DI void lds_row_read(f32x4 (&a)[16], unsigned addr);
template <> DI void lds_row_read<16>(f32x4 (&a)[16], unsigned addr) {
  asm volatile("ds_read_b128 %0, %16\n\tds_read_b128 %1, %16 offset:16\n\tds_read_b128 %2, %16 offset:32\n\tds_read_b128 %3, %16 offset:48\n\t"
               "ds_read_b128 %4, %16 offset:64\n\tds_read_b128 %5, %16 offset:80\n\tds_read_b128 %6, %16 offset:96\n\tds_read_b128 %7, %16 offset:112\n\t"
               "ds_read_b128 %8, %16 offset:128\n\tds_read_b128 %9, %16 offset:144\n\tds_read_b128 %10, %16 offset:160\n\tds_read_b128 %11, %16 offset:176\n\t"
               "ds_read_b128 %12, %16 offset:192\n\tds_read_b128 %13, %16 offset:208\n\tds_read_b128 %14, %16 offset:224\n\tds_read_b128 %15, %16 offset:240\n\ts_waitcnt lgkmcnt(0)"
               : "=&v"(a[0]), "=&v"(a[1]), "=&v"(a[2]), "=&v"(a[3]), "=&v"(a[4]), "=&v"(a[5]), "=&v"(a[6]), "=&v"(a[7]), "=&v"(a[8]), "=&v"(a[9]), "=&v"(a[10]), "=&v"(a[11]), "=&v"(a[12]), "=&v"(a[13]), "=&v"(a[14]), "=&v"(a[15])
               : "v"(addr) : "memory");
}
template <> DI void lds_row_read<12>(f32x4 (&a)[16], unsigned addr) {
  asm volatile("ds_read_b128 %0, %12\n\tds_read_b128 %1, %12 offset:16\n\tds_read_b128 %2, %12 offset:32\n\tds_read_b128 %3, %12 offset:48\n\t"
               "ds_read_b128 %4, %12 offset:64\n\tds_read_b128 %5, %12 offset:80\n\tds_read_b128 %6, %12 offset:96\n\tds_read_b128 %7, %12 offset:112\n\t"
               "ds_read_b128 %8, %12 offset:128\n\tds_read_b128 %9, %12 offset:144\n\tds_read_b128 %10, %12 offset:160\n\tds_read_b128 %11, %12 offset:176\n\ts_waitcnt lgkmcnt(0)"
               : "=&v"(a[0]), "=&v"(a[1]), "=&v"(a[2]), "=&v"(a[3]), "=&v"(a[4]), "=&v"(a[5]), "=&v"(a[6]), "=&v"(a[7]), "=&v"(a[8]), "=&v"(a[9]), "=&v"(a[10]), "=&v"(a[11])
               : "v"(addr) : "memory");
}
template <> DI void lds_row_read<8>(f32x4 (&a)[16], unsigned addr) {
  asm volatile("ds_read_b128 %0, %8\n\tds_read_b128 %1, %8 offset:16\n\tds_read_b128 %2, %8 offset:32\n\tds_read_b128 %3, %8 offset:48\n\t"
               "ds_read_b128 %4, %8 offset:64\n\tds_read_b128 %5, %8 offset:80\n\tds_read_b128 %6, %8 offset:96\n\tds_read_b128 %7, %8 offset:112\n\ts_waitcnt lgkmcnt(0)"
               : "=&v"(a[0]), "=&v"(a[1]), "=&v"(a[2]), "=&v"(a[3]), "=&v"(a[4]), "=&v"(a[5]), "=&v"(a[6]), "=&v"(a[7])
               : "v"(addr) : "memory");
}
template <> DI void lds_row_read<4>(f32x4 (&a)[16], unsigned addr) {
  asm volatile("ds_read_b128 %0, %4\n\tds_read_b128 %1, %4 offset:16\n\tds_read_b128 %2, %4 offset:32\n\tds_read_b128 %3, %4 offset:48\n\ts_waitcnt lgkmcnt(0)"
               : "=&v"(a[0]), "=&v"(a[1]), "=&v"(a[2]), "=&v"(a[3]) : "v"(addr) : "memory");
}
template <int J> DI void subst_rows(float (&t)[64], unsigned abase) {
  if constexpr (J < 63) {
    constexpr int I40 = (J + 1) / 4, G0 = I40 / 4;
    const float xj = t[J];
    if constexpr (G0 < 2) {
      f32x4 a[16]; lds_row_read<8 - 4 * G0>(a, abase + (unsigned)((J * 68 + 16 * G0) * 4));
#pragma unroll
      for (int i4 = (I40 > 4 * G0 ? I40 : 4 * G0); i4 < 8; ++i4) { const f32x4 v = a[i4 - 4 * G0];
        t[4 * i4] -= v[0] * xj; t[4 * i4 + 1] -= v[1] * xj; t[4 * i4 + 2] -= v[2] * xj; t[4 * i4 + 3] -= v[3] * xj; }
    }
    { constexpr int G1 = G0 < 2 ? 2 : G0;
      f32x4 a[16]; lds_row_read<16 - 4 * G1>(a, abase + (unsigned)((J * 68 + 16 * G1) * 4));
#pragma unroll
      for (int i4 = (I40 > 4 * G1 ? I40 : 4 * G1); i4 < 16; ++i4) { const f32x4 v = a[i4 - 4 * G1];
        t[4 * i4] -= v[0] * xj; t[4 * i4 + 1] -= v[1] * xj; t[4 * i4 + 2] -= v[2] * xj; t[4 * i4 + 3] -= v[3] * xj; }
    }
    subst_rows<J + 1>(t, abase);
  }
}
constexpr int CP_RS = 272;
constexpr int CP_K = 0, CP_Q = 17408, CP_VB = 34816, CP_KG = 52224, CP_AF = 69632  , CP_TB = 87040  , CP_GC = 96256, CP_BETA = 96512;
DI void chunkprep_phase(const Params& p, lds_t lds, int wv) { TIDS(); float* QS1 = (float*)(p.ws + 52 * MiB);
  unsigned char* ws = p.ws;
  const bf16_t* DQKV = (const bf16_t*)(ws + WS_DQKV); const float* BG = (const float*)(ws + WS_BG);
  bf16_t* QD = (bf16_t*)(ws + WS_QD); bf16_t* KDT = (bf16_t*)(ws + WS_KDT); bf16_t* Ug = (bf16_t*)(ws + WS_U); bf16_t* Wg = (bf16_t*)(ws + WS_W);
  bf16_t* QK = (bf16_t*)((unsigned char*)p.out + DO_QK); float* GL = (float*)(ws + WS_GL);
  LAS float* gcs = (LAS float*)(lds + CP_GC); LAS float* betas = (LAS float*)(lds + CP_BETA); LAS float* Af = (LAS float*)(lds + CP_AF);
  const int fr = lane & 15, fq = lane >> 4;
  for (int unit = blockIdx.x; unit < 4096; unit += gridDim.x) {
    const int bh = unit >> 6, n = unit & 63, b = bh >> 3, h = bh & 7;
    const size_t row0 = (size_t)b * L_ + n * 64;
    __syncthreads();
    if (wave == 0) {
      const float db = BG[(row0 + lane) * 16 + h], da = BG[(row0 + lane) * 16 + 8 + h];
      const float xx = da + p.dt_bias[h]; const float sp = (xx > 20.f) ? xx : log1pf(__expf(xx));
      float gg = -__expf(p.a_log[h]) * sp;
#pragma unroll
      for (int o = 1; o < 64; o <<= 1) { const float t = BPERM((lane - o) & 63, gg); if (lane >= o) gg += t; }
      gcs[lane] = gg; betas[lane] = sigmoidf_(db);
      if (lane == 63) GL[unit] = __expf(gg);
      QS1[(size_t)bh * L_ + n * 64 + lane] = 1.f;
    }
    float val[6][8];
#pragma unroll
    for (int i = 0; i < 6; ++i) { const int it = (tid >> 4) + 32 * i, s = it >> 6, c = it & 63, tpos = n * 64 + c; const int col = s * 1024 + h * 128 + fr * 8;
      float y[8];
#pragma unroll
      for (int e = 0; e < 8; ++e) y[e] = 0.f;
#pragma unroll
      for (int j = 0; j < 4; ++j) { if (tpos - 3 + j >= 0) {
          const u32x4 xv = *(const u32x4*)(DQKV + (row0 + c - 3 + j) * 3072 + col); const f32x4 w0 = *(const f32x4*)(p.conv_w + (size_t)j * 3072 + col), w1 = *(const f32x4*)(p.conv_w + (size_t)j * 3072 + col + 4);
          y[0] += w0[0] * bflo(xv.x); y[1] += w0[1] * bfhi(xv.x); y[2] += w0[2] * bflo(xv.y); y[3] += w0[3] * bfhi(xv.y);
          y[4] += w1[0] * bflo(xv.z); y[5] += w1[1] * bfhi(xv.z); y[6] += w1[2] * bflo(xv.w); y[7] += w1[3] * bfhi(xv.w); } }
      float ss = 0.f;
#pragma unroll
      for (int e = 0; e < 8; ++e) { y[e] = siluf_(y[e]); ss += y[e] * y[e]; }
      ss = sum16(ss, lane);
      float scl = 1.f; if (s < 2) scl = 1.f / sqrtf(ss + 1e-6f); if (s == 0) scl *= 0.08838834764831845f;
#pragma unroll
      for (int e = 0; e < 8; ++e) val[i][e] = y[e] * scl; }
    __syncthreads();
    const float gclast = gcs[63];
#pragma unroll
    for (int i = 0; i < 6; ++i) { const int it = (tid >> 4) + 32 * i, s = it >> 6, c = it & 63; const float gc = gcs[c], be = betas[c];
      if (s == 0) { const float eg = __expf(gc);
        u32x4 a, d; a.x = pk2(val[i][0], val[i][1]); a.y = pk2(val[i][2], val[i][3]); a.z = pk2(val[i][4], val[i][5]); a.w = pk2(val[i][6], val[i][7]);
        d.x = pk2(val[i][0] * eg, val[i][1] * eg); d.y = pk2(val[i][2] * eg, val[i][3] * eg); d.z = pk2(val[i][4] * eg, val[i][5] * eg); d.w = pk2(val[i][6] * eg, val[i][7] * eg);
        *(LAS u32x4*)(lds + CP_Q + c * CP_RS + fr * 16) = a; *(u32x4*)(QD + ((size_t)bh * L_ + n * 64 + c) * 128 + fr * 8) = d;
      } else if (s == 1) { const float eb = be * __expf(gc), ed = __expf(gclast - gc);
        u32x4 a, d; a.x = pk2(val[i][0], val[i][1]); a.y = pk2(val[i][2], val[i][3]); a.z = pk2(val[i][4], val[i][5]); a.w = pk2(val[i][6], val[i][7]);
        d.x = pk2(val[i][0] * eb, val[i][1] * eb); d.y = pk2(val[i][2] * eb, val[i][3] * eb); d.z = pk2(val[i][4] * eb, val[i][5] * eb); d.w = pk2(val[i][6] * eb, val[i][7] * eb);
        *(LAS u32x4*)(lds + CP_K + c * CP_RS + fr * 16) = a; *(LAS u32x4*)(lds + CP_KG + c * CP_RS + fr * 16) = d;
        bf16_t* kt = KDT + ((size_t)unit * 128 + fr * 8) * 64 + c;
#pragma unroll
        for (int e = 0; e < 8; ++e) kt[e * 64] = (bf16_t)f2bf(val[i][e] * ed);
      } else { u32x4 d; d.x = pk2(val[i][0] * be, val[i][1] * be); d.y = pk2(val[i][2] * be, val[i][3] * be); d.z = pk2(val[i][4] * be, val[i][5] * be); d.w = pk2(val[i][6] * be, val[i][7] * be);
        *(LAS u32x4*)(lds + CP_VB + c * CP_RS + fr * 16) = d; } }
    __syncthreads();
    {
      const int rt = wave & 3; lds_t ap = lds + (wave < 4 ? CP_K : CP_Q) + (16 * rt + fr) * CP_RS + fq * 16;
      bf16x8 af[4];
#pragma unroll
      for (int ks = 0; ks < 4; ++ks) af[ks] = lds_ld16(ap + ks * 64);
#pragma unroll
      for (int ct = 0; ct < 4; ++ct) { f32x4 acc = {0.f, 0.f, 0.f, 0.f}; lds_t bp = lds + CP_K + (16 * ct + fr) * CP_RS + fq * 16;
#pragma unroll
        for (int ks = 0; ks < 4; ++ks) acc = MFMA16(af[ks], lds_ld16(bp + ks * 64), acc);
        const int s = 16 * ct + fr; const float gs = gcs[s];
#pragma unroll
        for (int j = 0; j < 4; ++j) { const int c = 16 * rt + 4 * fq + j; const float dec = __expf(gcs[c] - gs);
          if (wave < 4) Af[s * 68 + c] = (c > s) ? betas[c] * acc[j] * dec : 0.f;
          else QK[((size_t)unit * 64 + c) * 64 + s] = (bf16_t)f2bf((c >= s) ? acc[j] * dec : 0.f); } }
    }
    __syncthreads();
    if (wave == 0) {
      float t[64];
      unsigned abase = (unsigned)(size_t)Af; asm volatile("" : "+v"(abase));
#pragma unroll
      for (int i = 0; i < 64; ++i) t[i] = (lane == i) ? 1.f : 0.f;
      subst_rows<0>(t, abase);
#pragma unroll
      for (int i = 0; i < 64; ++i) *(LAS bf16_t*)(lds + CP_TB + i * 144 + lane * 2) = (bf16_t)f2bf(t[i]);
    }
    __syncthreads();
    {
      const int rt = wave & 3; lds_t tp = lds + CP_TB + (16 * rt + fr) * 144 + fq * 16;
      const bf16x8 a0 = lds_ld16(tp), a1 = lds_ld16(tp + 64);
      lds_t xb = lds + (wave < 4 ? CP_VB : CP_KG) + (fq * 8 + (fr >> 2)) * CP_RS + (fr & 3) * 8;
      bf16_t* og = (wave < 4 ? Ug : Wg) + ((size_t)bh * L_ + n * 64 + 16 * rt + 4 * fq) * 128 + fr;
#pragma unroll
      for (int ct = 0; ct < 8; ++ct) { f32x4 acc = {0.f, 0.f, 0.f, 0.f};
        { const s16x4 lo = lds_tr(xb + ct * 32), hi = lds_tr(xb + 4 * CP_RS + ct * 32); acc = MFMA16(a0, __builtin_shufflevector(lo, hi, 0, 1, 2, 3, 4, 5, 6, 7), acc); }
        { const s16x4 lo = lds_tr(xb + 32 * CP_RS + ct * 32), hi = lds_tr(xb + 36 * CP_RS + ct * 32); acc = MFMA16(a1, __builtin_shufflevector(lo, hi, 0, 1, 2, 3, 4, 5, 6, 7), acc); }
#pragma unroll
        for (int j = 0; j < 4; ++j) og[(size_t)j * 128 + ct * 16] = (bf16_t)f2bf(acc[j]); }
    }
  }
}
constexpr int CW_TB = 0  , CW_CH = 9216  , CW_RAW = 14336  , CW_AT = 0  , CW_TAB = 18624  , CW_WAVE = 19648;
constexpr size_t WS_QS = 52 * MiB;
DI void conv8(const bf16_t* base, unsigned eoff, int tpos, const f32x4 (&w)[4][2], float (&y)[8]) {
#pragma unroll
  for (int e = 0; e < 8; ++e) y[e] = 0.f;
#pragma unroll
  for (int j = 0; j < 4; ++j) if (tpos - 3 + j >= 0) { const u32x4 xv = *(const u32x4*)(base + (eoff + (unsigned)(j * 3072) - 9216u));
      y[0] += w[j][0][0] * bflo(xv.x); y[1] += w[j][0][1] * bfhi(xv.x); y[2] += w[j][0][2] * bflo(xv.y); y[3] += w[j][0][3] * bfhi(xv.y);
      y[4] += w[j][1][0] * bflo(xv.z); y[5] += w[j][1][1] * bfhi(xv.z); y[6] += w[j][1][2] * bflo(xv.w); y[7] += w[j][1][3] * bfhi(xv.w); }
#pragma unroll
  for (int e = 0; e < 8; ++e) y[e] = siluf_(y[e]);
}
DI void load_convw(const float* cw, int col, f32x4 (&w)[4][2]) {
#pragma unroll
  for (int j = 0; j < 4; ++j) { w[j][0] = *(const f32x4*)(cw + (size_t)j * 3072 + col); w[j][1] = *(const f32x4*)(cw + (size_t)j * 3072 + col + 4); }
}
DI bf16x8 pack_y(const float (&y)[8], float s) { u32x4 v; v.x = pk2(y[0] * s, y[1] * s); v.y = pk2(y[2] * s, y[3] * s); v.z = pk2(y[4] * s, y[5] * s); v.w = pk2(y[6] * s, y[7] * s); return __builtin_bit_cast(bf16x8, v); }
#define TRI(r, c) ((r) * ((r) + 1) / 2 + (c))
template <int J> DI void subst_rl(float (&t)[64], const f32x4 (&A)[10]) {
  if constexpr (J < 63) {
    const float xj = t[J];
#pragma unroll
    for (int i = J + 1; i < 64; ++i) {
      const float a = __builtin_bit_cast(float, __builtin_amdgcn_readlane(__builtin_bit_cast(int, A[TRI(i >> 4, J >> 4)][i & 3]), 16 * ((i & 15) >> 2) + (J & 15)));
      t[i] -= a * xj; }
    if constexpr ((J & 3) == 3) __builtin_amdgcn_sched_barrier(0);
    subst_rl<J + 1>(t, A);
  }
}
DI void raw_issue(u32x4 (&raw)[5], const bf16_t* DQKV, unsigned rowbase  , int n64, int colbase, int ln) {
  asm volatile("" : "+v"(ln));
#pragma unroll
  for (int i = 0; i < 5; ++i) { const int item = ln + 64 * i, rr = item >> 2, pc = item & 3; raw[i] = (u32x4){0u, 0u, 0u, 0u};
    if (item < 268 && n64 - 3 + rr >= 0) raw[i] = *(const u32x4*)(DQKV + ((rowbase + (unsigned)rr) * 3072u + (unsigned)(colbase + pc * 8))); }
}
DI void raw_commit(lds_t rawl, const u32x4 (&raw)[5], int ln) {
  asm volatile("" : "+v"(ln));
#pragma unroll
  for (int i = 0; i < 5; ++i) { const int item = ln + 64 * i; if (item < 268) *(LAS u32x4*)(rawl + item * 16) = raw[i]; }
  asm volatile("" ::: "memory");
}
DI void conv8l(lds_t rawl, int c, int fq, const f32x4 (&w)[4][2], float (&y)[8]) {
#pragma unroll
  for (int e = 0; e < 8; ++e) y[e] = 0.f;
#pragma unroll
  for (int j = 0; j < 4; ++j) { const u32x4 xv = *(LAS u32x4*)(rawl + (c + j) * 64 + fq * 16);
    y[0] += w[j][0][0] * bflo(xv.x); y[1] += w[j][0][1] * bfhi(xv.x); y[2] += w[j][0][2] * bflo(xv.y); y[3] += w[j][0][3] * bfhi(xv.y);
    y[4] += w[j][1][0] * bflo(xv.z); y[5] += w[j][1][1] * bfhi(xv.z); y[6] += w[j][1][2] * bflo(xv.w); y[7] += w[j][1][3] * bfhi(xv.w); }
#pragma unroll
  for (int e = 0; e < 8; ++e) y[e] = siluf_(y[e]);
}
#ifndef NCM
#define NCM 63
#endif
DI void chunkprep_wave(const Params& p, lds_t lds, int wv) {
  const int wave = wv;
  unsigned char* ws = p.ws;
  const bf16_t* DQKV = (const bf16_t*)(ws + WS_DQKV); const float* BG = (const float*)(ws + WS_BG);
  bf16_t* Qg = (bf16_t*)(ws + WS_QD); bf16_t* KDT = (bf16_t*)(ws + WS_KDT); bf16_t* Ug = (bf16_t*)(ws + WS_U); bf16_t* Wg = (bf16_t*)(ws + WS_W);
  bf16_t* QK = (bf16_t*)((unsigned char*)p.out + DO_QK); float* GL = (float*)(ws + WS_GL); float* QS = (float*)(ws + WS_QS);
  lds_t wl = lds + wave * CW_WAVE; LAS float* tab = (LAS float*)(wl + CW_TAB);
  for (int unit = blockIdx.x * 8 + wave; unit < 4096; unit += gridDim.x * 8) {
    const int ln = lane_id();
    const int fr = ln & 15, fq = ln >> 4;
    const int bh = unit >> 6, n = unit & 63, b = bh >> 3, h = bh & 7;
    const size_t row0 = (size_t)b * L_ + n * 64, trow0 = (size_t)bh * L_ + n * 64;
    float gclast;
    { const float db = BG[((unsigned)row0 + ln) * 16u + h], da = BG[((unsigned)row0 + ln) * 16u + 8 + h];
      const float xx = da + p.dt_bias[h]; const float sp = (xx > 20.f) ? xx : __logf(1.f + __expf(xx));
      float gg = -__expf(p.a_log[h]) * sp;
#pragma unroll
      for (int o = 1; o < 64; o <<= 1) { const float tt = BPERM((ln - o) & 63, gg); if (ln >= o) gg += tt; }
      tab[ln] = gg; tab[64 + ln] = sigmoidf_(db); gclast = __builtin_bit_cast(float, __builtin_amdgcn_readlane(__builtin_bit_cast(int, gg), 63));
      if ((NCM & 32) && ln == 63) GL[unit] = __expf(gg); }
#ifndef CPW
#define CPW 255
#endif
    f32x4 A[10]; u32x4 raw[5];
    const unsigned rowbase = (unsigned)row0 - 3u; const int kcol0 = 1024 + h * 128, qcol0 = h * 128, vcol0 = 2048 + h * 128;
    raw_issue(raw, DQKV, rowbase, n * 64, kcol0, ln);
    { f32x4 gq[10];
#pragma unroll
      for (int i = 0; i < 10; ++i) { A[i] = (f32x4){0.f, 0.f, 0.f, 0.f}; gq[i] = (f32x4){0.f, 0.f, 0.f, 0.f}; }
      float ssk[4] = {0.f, 0.f, 0.f, 0.f}, ssq[4] = {0.f, 0.f, 0.f, 0.f};
#pragma unroll 1
      for (int ks = 0; ks < 4; ++ks) {
        bf16x8 kc[4], qc[4];
        { const int col = 1024 + h * 128 + 32 * ks + 8 * fq; f32x4 w[4][2]; load_convw(p.conv_w, col, w);
          raw_commit(wl + CW_RAW, raw, ln); raw_issue(raw, DQKV, rowbase, n * 64, qcol0 + 32 * ks, ln);
#pragma unroll
          for (int rt = 0; rt < 4; ++rt) { float y[8]; conv8l(wl + CW_RAW, 16 * rt + fr, fq, w, y);
#pragma unroll
            for (int e = 0; e < 8; ++e) ssk[rt] += y[e] * y[e];
            kc[rt] = pack_y(y, 1.f); __builtin_amdgcn_sched_barrier(0); } }
        __builtin_amdgcn_sched_barrier(0);
        { const int col = h * 128 + 32 * ks + 8 * fq; f32x4 w[4][2]; load_convw(p.conv_w, col, w);
          raw_commit(wl + CW_RAW, raw, ln); raw_issue(raw, DQKV, rowbase, n * 64, (ks < 3) ? kcol0 + 32 * (ks + 1) : vcol0, ln);
#pragma unroll
          for (int rt = 0; rt < 4; ++rt) { float y[8]; conv8l(wl + CW_RAW, 16 * rt + fr, fq, w, y);
#pragma unroll
            for (int e = 0; e < 8; ++e) ssq[rt] += y[e] * y[e];
            qc[rt] = pack_y(y, 1.f);
            { const int lq = lane_id(); if (NCM & 1) *(bf16x8*)(Qg + (((unsigned)trow0 + 16 * rt + (lq & 15)) * 128u + 32 * ks + 8 * (lq >> 4))) = qc[rt]; } __builtin_amdgcn_sched_barrier(0); } }
        __builtin_amdgcn_sched_barrier(0);
#pragma unroll
        for (int rt = 0; rt < 4; ++rt)
#pragma unroll
          for (int ct = 0; ct <= rt; ++ct) { A[TRI(rt, ct)] = MFMA16(kc[rt], kc[ct], A[TRI(rt, ct)]); gq[TRI(rt, ct)] = MFMA16(qc[rt], kc[ct], gq[TRI(rt, ct)]); }
        __builtin_amdgcn_sched_barrier(0);
      }
      int lnr_ = lane_id(); unsigned wlru = (unsigned)(size_t)lds + (unsigned)(wave * CW_WAVE); asm volatile("" : "+s"(wlru));
      { const int ln = lnr_, fr = ln & 15, fq = ln >> 4; const lds_t wl = (lds_t)(size_t)wlru; LAS float* tab = (LAS float*)(wl + CW_TAB);
#pragma unroll
      for (int rt = 0; rt < 4; ++rt) { float s = ssk[rt]; s += BPERM(ln ^ 16, s); s += BPERM(ln ^ 32, s); float q = ssq[rt]; q += BPERM(ln ^ 16, q); q += BPERM(ln ^ 32, q);
        const float rq = 0.08838834764831845f / sqrtf(q + 1e-6f);
        if (fq == 0) { tab[128 + 16 * rt + fr] = 1.f / sqrtf(s + 1e-6f); tab[192 + 16 * rt + fr] = rq; if (NCM & 1) QS[(unsigned)trow0 + 16 * rt + fr] = rq * __expf(tab[16 * rt + fr]); } }
      }
      asm volatile("" ::: "memory");
      { int lns_ = lane_id(); const int fr = lns_ & 15, fq = lns_ >> 4; unsigned wlsu = (unsigned)(size_t)lds + (unsigned)(wave * CW_WAVE); asm volatile("" : "+s"(wlsu)); const lds_t wl = (lds_t)(size_t)wlsu; LAS float* tab = (LAS float*)(wl + CW_TAB);
#pragma unroll
      for (int rt = 0; rt < 4; ++rt) {
        float gcr[4], ber[4], rkr[4], rqr[4];
#pragma unroll
        for (int j = 0; j < 4; ++j) { const int c = 16 * rt + 4 * fq + j; gcr[j] = tab[c]; ber[j] = tab[64 + c]; rkr[j] = tab[128 + c]; rqr[j] = tab[192 + c]; }
#pragma unroll
        for (int ct = 0; ct < 4; ++ct) {
          bf16_t* qko = QK + (((unsigned)unit * 64 + 16 * rt + 4 * fq) * 64u + 16 * ct + fr);
          if (ct > rt) {
#pragma unroll
            for (int j = 0; j < 4; ++j) { if (NCM & 2) qko[j * 64] = 0; *(LAS float*)(wl + CW_AT + ((16 * ct + fr) * 68 + 16 * rt + 4 * fq + j) * 4) = 0.f; }
            continue; }
          const int s = 16 * ct + fr; const float gs = tab[s], rks = tab[128 + s];
#pragma unroll
          for (int j = 0; j < 4; ++j) { const int c = 16 * rt + 4 * fq + j; const float dec = __expf(gcr[j] - gs) * rks;
            A[TRI(rt, ct)][j] = (c > s) ? A[TRI(rt, ct)][j] * rkr[j] * ber[j] * dec : 0.f;
            *(LAS float*)(wl + CW_AT + (s * 68 + c) * 4) = A[TRI(rt, ct)][j];
            if (NCM & 2) qko[j * 64] = (bf16_t)f2bf((c >= s) ? gq[TRI(rt, ct)][j] * rqr[j] * dec : 0.f); } } }
      }
    }
    __builtin_amdgcn_sched_barrier(0);
#if CPW & 4
    { float t[64]; const int ln = lane_id();
#pragma unroll
      for (int i = 0; i < 64; ++i) t[i] = (ln == i) ? 1.f : 0.f;
      asm volatile("" ::: "memory");
      { unsigned abase = (unsigned)(size_t)(wl + CW_AT); asm volatile("" : "+v"(abase)); subst_rows<0>(t, abase); }
      asm volatile("" ::: "memory");
#pragma unroll
      for (int i = 0; i < 64; ++i) *(LAS bf16_t*)(wl + CW_TB + i * 144 + ln * 2) = (bf16_t)f2bf(t[i]);
      asm volatile("" ::: "memory"); }
#endif
    __builtin_amdgcn_sched_barrier(0);
    int ln8 = lane_id(); { const int fr = ln8 & 15, fq = ln8 >> 4; unsigned wl8u = (unsigned)(size_t)lds + (unsigned)(wave * CW_WAVE); asm volatile("" : "+s"(wl8u)); const lds_t wl = (lds_t)(size_t)wl8u; LAS float* tab = (LAS float*)(wl + CW_TAB);
    bf16x8 ta[4][2];
#pragma unroll
    for (int rt = 0; rt < 4; ++rt) { ta[rt][0] = lds_ld16(wl + CW_TB + (16 * rt + fr) * 144 + fq * 16); ta[rt][1] = lds_ld16(wl + CW_TB + (16 * rt + fr) * 144 + 64 + fq * 16); }
    lds_t chw = wl + CW_CH + fr * 80 + fq * 16;
    lds_t chr = wl + CW_CH + (8 * fq + (fr >> 2)) * 80 + (fr & 3) * 8;
#if CPW & 1
#pragma unroll 1
    for (int ks = 0; ks < 4; ++ks) { const int col = 2048 + h * 128 + 32 * ks + 8 * fq; f32x4 w[4][2]; load_convw(p.conv_w, col, w);
      raw_commit(wl + CW_RAW, raw, ln8); raw_issue(raw, DQKV, rowbase, n * 64, (ks < 3) ? vcol0 + 32 * (ks + 1) : kcol0, ln8);
#pragma unroll
      for (int rt = 0; rt < 4; ++rt) { float y[8]; conv8l(wl + CW_RAW, 16 * rt + fr, fq, w, y);
        *(LAS bf16x8*)(chw + rt * 1280) = pack_y(y, tab[64 + 16 * rt + fr]); if (rt & 1) __builtin_amdgcn_sched_barrier(0); }
      asm volatile("" ::: "memory");
#pragma unroll
      for (int ct2 = 0; ct2 < 2; ++ct2) {
        const s16x4 l0 = lds_tr(chr + ct2 * 32), h0 = lds_tr(chr + 320 + ct2 * 32), l1 = lds_tr(chr + 2560 + ct2 * 32), h1 = lds_tr(chr + 2880 + ct2 * 32);
        const bf16x8 b0 = __builtin_shufflevector(l0, h0, 0, 1, 2, 3, 4, 5, 6, 7), b1 = __builtin_shufflevector(l1, h1, 0, 1, 2, 3, 4, 5, 6, 7);
#pragma unroll
        for (int rt = 0; rt < 4; ++rt) { f32x4 acc = {0.f, 0.f, 0.f, 0.f}; acc = MFMA16(ta[rt][0], b0, acc); acc = MFMA16(ta[rt][1], b1, acc);
          { u32x2 uv2; uv2.x = pk2(acc[0], acc[1]); uv2.y = pk2(acc[2], acc[3]);
            if (NCM & 4) *(u32x2*)(Ug + ((((unsigned)unit * 4 + ks) * 4 + rt) * 64 + ln8) * 8u + ct2 * 4) = uv2; } } }
      __builtin_amdgcn_sched_barrier(0); }
#endif
    __builtin_amdgcn_sched_barrier(0);
#if CPW & 2
#pragma unroll 1
    for (int ks = 0; ks < 4; ++ks) { const int col = 1024 + h * 128 + 32 * ks + 8 * fq; f32x4 w[4][2]; load_convw(p.conv_w, col, w);
      bf16x8 kd[4];
      raw_commit(wl + CW_RAW, raw, ln8); if (ks < 3) raw_issue(raw, DQKV, rowbase, n * 64, kcol0 + 32 * (ks + 1), ln8);
#pragma unroll
      for (int rt = 0; rt < 4; ++rt) { float y[8]; conv8l(wl + CW_RAW, 16 * rt + fr, fq, w, y);
        const int c = 16 * rt + fr; const float gc = tab[c], rk = tab[128 + c];
        *(LAS bf16x8*)(chw + rt * 1280) = pack_y(y, rk * tab[64 + c] * __expf(gc)); kd[rt] = pack_y(y, rk * __expf(gclast - gc)); if (rt & 1) __builtin_amdgcn_sched_barrier(0); }
      asm volatile("" ::: "memory");
#pragma unroll
      for (int ct2 = 0; ct2 < 2; ++ct2) {
        const s16x4 l0 = lds_tr(chr + ct2 * 32), h0 = lds_tr(chr + 320 + ct2 * 32), l1 = lds_tr(chr + 2560 + ct2 * 32), h1 = lds_tr(chr + 2880 + ct2 * 32);
        const bf16x8 b0 = __builtin_shufflevector(l0, h0, 0, 1, 2, 3, 4, 5, 6, 7), b1 = __builtin_shufflevector(l1, h1, 0, 1, 2, 3, 4, 5, 6, 7);
#pragma unroll
        for (int rt = 0; rt < 4; ++rt) { f32x4 acc = {0.f, 0.f, 0.f, 0.f}; acc = MFMA16(ta[rt][0], b0, acc); acc = MFMA16(ta[rt][1], b1, acc);
          bf16_t* og = Wg + (((unsigned)trow0 + 16 * rt + 4 * fq) * 128u + 32 * ks + 16 * ct2 + fr);
#pragma unroll
          for (int j = 0; j < 4; ++j) if (NCM & 8) og[j * 128] = (bf16_t)f2bf(acc[j]); } }
      asm volatile("" ::: "memory");
#pragma unroll
      for (int rt = 0; rt < 4; ++rt) *(LAS bf16x8*)(chw + rt * 1280) = kd[rt];
      asm volatile("" ::: "memory");
#pragma unroll
      for (int ct2 = 0; ct2 < 2; ++ct2)
#pragma unroll
        for (int ks2 = 0; ks2 < 2; ++ks2) { const s16x4 lo = lds_tr(chr + ks2 * 2560 + ct2 * 32), hi = lds_tr(chr + ks2 * 2560 + 320 + ct2 * 32);
          if (NCM & 16) *(bf16x8*)(KDT + (((unsigned)unit * 128 + 32 * ks + 16 * ct2 + fr) * 64u + 32 * ks2 + 8 * fq)) = __builtin_shufflevector(lo, hi, 0, 1, 2, 3, 4, 5, 6, 7); }
      asm volatile("" ::: "memory"); __builtin_amdgcn_sched_barrier(0); }
#endif
    }
  }
}
constexpr int SC_ST = 0  , SC_VT = 8704  ;
template <int LMUL> DI void scan_phase(const Params& p, lds_t lds, int wv) { TIDS();
  unsigned char* ws = p.ws;
  const bf16_t* QD = (const bf16_t*)(ws + WS_QD); const bf16_t* KDT = (const bf16_t*)(ws + WS_KDT); const bf16_t* Ug = (const bf16_t*)(ws + WS_U); const bf16_t* Wg = (const bf16_t*)(ws + WS_W);
  const bf16_t* QK = (const bf16_t*)((const unsigned char*)p.out + DO_QK); const float* GL = (const float*)(ws + WS_GL); bf16_t* ORAW = (bf16_t*)(ws + WS_ORAW); const float* QS = (const float*)(ws + WS_QS);
  const int fr = lane & 15, fq = lane >> 4, rt = wave & 3;
  for (int unit0 = blockIdx.x; unit0 < 256; unit0 += gridDim.x) {
    const int unit = (gridDim.x == 256) ? ((((unit0 & 7) * 8 + (unit0 >> 5)) << 2) | ((unit0 >> 3) & 3)) : unit0;
    const int bh = unit >> 2, sl = unit & 3, b = bh >> 3, h = bh & 7;
    __syncthreads();
    for (int i = tid; i < (8704 + 4608) / 4; i += 512) ((LAS unsigned*)lds)[i] = 0u;
    f32x4 sacc[2] = {{0.f, 0.f, 0.f, 0.f}, {0.f, 0.f, 0.f, 0.f}};
    const bf16_t* arow = (wave < 4 ? Wg : QD) + ((size_t)bh * L_ + 16 * rt + fr) * 128 + fq * 8;
    const bf16_t* krow = KDT + ((size_t)bh * 64 * 128 + 16 * wave + fr) * 64 + fq * 8;
    const bf16_t* qkrow = QK + ((size_t)bh * 64 * 64 + 16 * rt + fr) * 64 + fq * 8;
    const size_t qkstep = (wave >= 4) ? 4096 : 0, ustep = (wave < 4) ? 8192 : 0, qsstep = (wave >= 4) ? 64 : 0;
    const bf16_t* urow = Ug + ((size_t)((bh * 64) * 4 + sl) * 4 + rt) * 512 + lane * 8;
    const float* qsrow = QS + (size_t)bh * L_ + 16 * rt + 4 * fq;
    bf16_t* orow = ORAW + ((size_t)b * L_ + 16 * rt + 4 * fq) * 1024 + h * 128 + sl * 32 + fr;
    bf16_t* obase = (wave >= 4) ? orow : (bf16_t*)(ws + 54 * MiB) + ((size_t)blockIdx.x * 4 + wave) * 2048 + 32 * fq + fr;     const size_t ostep = (wave >= 4) ? 65536 : 0;
#define SC_DECL(B) bf16x8 B##af[4], B##kf[2], B##qk[2]; u32x4 B##uq; f32x4 B##qs; float B##gl
#define SC_LOADB(B, nn0) do { const int nn = (nn0) * LMUL; _Pragma("unroll") for (int ks = 0; ks < 4; ++ks) B##af[ks] = *(const bf16x8*)(arow + (size_t)(nn) * 8192 + ks * 32); \
      _Pragma("unroll") for (int ks = 0; ks < 2; ++ks) { B##kf[ks] = *(const bf16x8*)(krow + (size_t)(nn) * 8192 + ks * 32); B##qk[ks] = *(const bf16x8*)(qkrow + (size_t)(nn) * qkstep + ks * 32); } \
      B##uq = *(const u32x4*)(urow + (size_t)(nn) * ustep); \
      B##qs = *(const f32x4*)(qsrow + (size_t)(nn) * qsstep); \
      B##gl = __builtin_bit_cast(float, __builtin_amdgcn_readlane(__builtin_bit_cast(int, glv), (nn))); } while (0)
#define SC_BAR() do { asm volatile("s_waitcnt lgkmcnt(0)" ::: "memory"); __builtin_amdgcn_s_barrier(); asm volatile("" ::: "memory"); } while (0)
#define SC_STEP(B, nn) do { \
      f32x4 acc[2]; bf16x8 sb[2][4]; \
      _Pragma("unroll") for (int ct = 0; ct < 2; ++ct) { acc[ct] = (f32x4){0.f, 0.f, 0.f, 0.f}; lds_t sp = lds + SC_ST + (16 * ct + fr) * 272 + fq * 16; \
        _Pragma("unroll") for (int ks = 0; ks < 4; ++ks) sb[ct][ks] = lds_ld16(sp + ks * 64); } \
      __builtin_amdgcn_sched_barrier(0); \
      _Pragma("unroll") for (int ks = 0; ks < 4; ++ks) { acc[0] = MFMA16(B##af[ks], sb[0][ks], acc[0]); acc[1] = MFMA16(B##af[ks], sb[1][ks], acc[1]); } \
      __builtin_amdgcn_sched_barrier(0); \
      if (wave < 4) { \
        { u32x2 v; v.x = pk2(bflo(B##uq.x) - acc[0][0], bfhi(B##uq.x) - acc[0][1]); v.y = pk2(bflo(B##uq.y) - acc[0][2], bfhi(B##uq.y) - acc[0][3]); \
          *(LAS u32x2*)(lds + SC_VT + fr * 144 + (16 * rt + 4 * fq) * 2) = v; \
          v.x = pk2(bflo(B##uq.z) - acc[1][0], bfhi(B##uq.z) - acc[1][1]); v.y = pk2(bflo(B##uq.w) - acc[1][2], bfhi(B##uq.w) - acc[1][3]); \
          *(LAS u32x2*)(lds + SC_VT + (16 + fr) * 144 + (16 * rt + 4 * fq) * 2) = v; } } \
      SC_BAR(); \
      bf16x8 vb[2][2]; \
      _Pragma("unroll") for (int ct = 0; ct < 2; ++ct) _Pragma("unroll") for (int ks = 0; ks < 2; ++ks) vb[ct][ks] = lds_ld16(lds + SC_VT + (16 * ct + fr) * 144 + ks * 64 + fq * 16); \
      { bf16_t* op = obase + (size_t)(nn) * ostep;     \
        _Pragma("unroll") for (int ct = 0; ct < 2; ++ct) { \
          _Pragma("unroll") for (int j = 0; j < 4; ++j) acc[ct][j] *= B##qs[j]; \
          _Pragma("unroll") for (int ks = 0; ks < 2; ++ks) acc[ct] = MFMA16(B##qk[ks], vb[ct][ks], acc[ct]); \
          _Pragma("unroll") for (int j = 0; j < 4; ++j) op[(size_t)j * 1024 + ct * 16] = (bf16_t)f2bf(acc[ct][j]); } } \
      _Pragma("unroll") for (int ct = 0; ct < 2; ++ct) { sacc[ct] = sacc[ct] * B##gl; \
        _Pragma("unroll") for (int ks = 0; ks < 2; ++ks) sacc[ct] = MFMA16(B##kf[ks], vb[ct][ks], sacc[ct]); \
        u32x2 v; v.x = pk2(sacc[ct][0], sacc[ct][1]); v.y = pk2(sacc[ct][2], sacc[ct][3]); \
        *(LAS u32x2*)(lds + SC_ST + (16 * ct + fr) * 272 + (16 * wave + 4 * fq) * 2) = v; } \
      if ((nn) + 3 < 64) SC_LOADB(B, (nn) + 3); \
      SC_BAR(); } while (0)
    const float glv = GL[bh * 64 + lane];
    SC_DECL(b0); SC_DECL(b1); SC_DECL(b2);
    SC_LOADB(b0, 0); SC_LOADB(b1, 1); SC_LOADB(b2, 2);
    __syncthreads();
    for (int n = 0; n < 63; n += 3) { SC_STEP(b0, n); SC_STEP(b1, n + 1); SC_STEP(b2, n + 2); }
    SC_STEP(b0, 63);
#undef SC_DECL
#undef SC_LOADB
#undef SC_BAR
#undef SC_STEP
  }
}
DI void gate_phase(const Params& p, int wv) { TIDS();
  const bf16_t* ORAW = (const bf16_t*)(p.ws + WS_ORAW); const bf16_t* ZG = (const bf16_t*)(p.ws + WS_ZG); bf16_t* OA = (bf16_t*)(p.ws + WS_OA);
  const int fr = tid & 15;
  const f32x4 w0 = *(const f32x4*)(p.dn_norm_w + fr * 8), w1 = *(const f32x4*)(p.dn_norm_w + fr * 8 + 4);
  for (size_t it = (size_t)blockIdx.x * 512 + tid; it < (size_t)T_ * 128; it += (size_t)gridDim.x * 512) {
    const size_t off = it * 8;
    const u32x4 q = *(const u32x4*)(ORAW + off);
    const f32x4 a0 = {bflo(q.x), bfhi(q.x), bflo(q.y), bfhi(q.y)}, a1 = {bflo(q.z), bfhi(q.z), bflo(q.w), bfhi(q.w)};
    float ss = (a0[0] * a0[0] + a0[1] * a0[1]) + (a0[2] * a0[2] + a0[3] * a0[3]) + (a1[0] * a1[0] + a1[1] * a1[1]) + (a1[2] * a1[2] + a1[3] * a1[3]);
    ss = sum16(ss, lane);
    const float r = 1.f / sqrtf(ss * (1.f / 128.f) + 1e-6f);
    const size_t row = it >> 7; const int col = (int)(it & 127) * 8;
    const u32x4 z = *(const u32x4*)(ZG + row * 3072 + col);
    u32x4 o;
    o.x = pk2(a0[0] * r * w0[0] * siluf_(bflo(z.x)), a0[1] * r * w0[1] * siluf_(bfhi(z.x)));
    o.y = pk2(a0[2] * r * w0[2] * siluf_(bflo(z.y)), a0[3] * r * w0[3] * siluf_(bfhi(z.y)));
    o.z = pk2(a1[0] * r * w1[0] * siluf_(bflo(z.z)), a1[1] * r * w1[1] * siluf_(bfhi(z.z)));
    o.w = pk2(a1[2] * r * w1[2] * siluf_(bflo(z.w)), a1[3] * r * w1[3] * siluf_(bfhi(z.w)));
    *(u32x4*)(OA + off) = o;
  }
}
constexpr size_t WS_X2B = S5;
DI void final_norm_phase(const Params& p, int wv) { TIDS();
  const int gw = blockIdx.x * 8 + wave, NGW = gridDim.x * 8;
  const bf16_t* X2 = (const bf16_t*)(p.ws + WS_X2B);
  const f32x4* wr = (const f32x4*)p.final_norm_w + lane * 2;
  const f32x4 g0 = wr[0], g1 = wr[1], g2 = wr[128], g3 = wr[129];
  for (int m = gw; m < T_; m += 2 * NGW) { const int m2 = (m + NGW < T_) ? m + NGW : m;
    const u32x4 a0 = *((const u32x4*)(X2 + (size_t)m * D_) + lane), a1 = *((const u32x4*)(X2 + (size_t)m * D_) + 64 + lane);
    const u32x4 b0 = *((const u32x4*)(X2 + (size_t)m2 * D_) + lane), b1 = *((const u32x4*)(X2 + (size_t)m2 * D_) + 64 + lane);
    const f32x4 va0 = {bflo(a0.x), bfhi(a0.x), bflo(a0.y), bfhi(a0.y)}, va1 = {bflo(a0.z), bfhi(a0.z), bflo(a0.w), bfhi(a0.w)}, va2 = {bflo(a1.x), bfhi(a1.x), bflo(a1.y), bfhi(a1.y)}, va3 = {bflo(a1.z), bfhi(a1.z), bflo(a1.w), bfhi(a1.w)};
    const f32x4 vb0 = {bflo(b0.x), bfhi(b0.x), bflo(b0.y), bfhi(b0.y)}, vb1 = {bflo(b0.z), bfhi(b0.z), bflo(b0.w), bfhi(b0.w)}, vb2 = {bflo(b1.x), bfhi(b1.x), bflo(b1.y), bfhi(b1.y)}, vb3 = {bflo(b1.z), bfhi(b1.z), bflo(b1.w), bfhi(b1.w)};
    const f32x4 qa = va0 * va0 + va1 * va1 + va2 * va2 + va3 * va3, qb = vb0 * vb0 + vb1 * vb1 + vb2 * vb2 + vb3 * vb3;
    const float ra = 1.f / sqrtf(wave_sum((qa[0] + qa[1]) + (qa[2] + qa[3]), lane) * (1.f / 1024.f) + 1e-6f), rb = 1.f / sqrtf(wave_sum((qb[0] + qb[1]) + (qb[2] + qb[3]), lane) * (1.f / 1024.f) + 1e-6f);
    f32x4* oa = (f32x4*)(p.out + (size_t)m * D_) + lane * 2; f32x4* ob = (f32x4*)(p.out + (size_t)m2 * D_) + lane * 2;
    oa[0] = va0 * ra * g0; oa[1] = va1 * ra * g1; oa[128] = va2 * ra * g2; oa[129] = va3 * ra * g3;
    ob[0] = vb0 * rb * g0; ob[1] = vb1 * rb * g1; ob[128] = vb2 * rb * g2; ob[129] = vb3 * rb * g3; }
}
DI void norm2_phase(const Params& p, int wv) { TIDS();
  const int gw = blockIdx.x * 8 + wave, NGW = gridDim.x * 8;
  const bf16_t* X1 = (const bf16_t*)(p.ws + WS_X1); bf16_t* H2 = (bf16_t*)(p.ws + WS_H2);
  const f32x4* wr = (const f32x4*)p.norm2_w + lane * 2;
  const f32x4 g0 = wr[0], g1 = wr[1], g2 = wr[128], g3 = wr[129];
  for (int m = gw; m < T_; m += 2 * NGW) { const int m2 = (m + NGW < T_) ? m + NGW : m;
    const u32x4 a0 = *((const u32x4*)(X1 + (size_t)m * D_) + lane), a1 = *((const u32x4*)(X1 + (size_t)m * D_) + 64 + lane);
    const u32x4 b0 = *((const u32x4*)(X1 + (size_t)m2 * D_) + lane), b1 = *((const u32x4*)(X1 + (size_t)m2 * D_) + 64 + lane);
    float va[16], vb[16];
#define UNP(dst, o, q) dst[o] = bflo(q.x); dst[o + 1] = bfhi(q.x); dst[o + 2] = bflo(q.y); dst[o + 3] = bfhi(q.y); dst[o + 4] = bflo(q.z); dst[o + 5] = bfhi(q.z); dst[o + 6] = bflo(q.w); dst[o + 7] = bfhi(q.w)
    UNP(va, 0, a0); UNP(va, 8, a1); UNP(vb, 0, b0); UNP(vb, 8, b1);
#undef UNP
    float sa = 0.f, sb = 0.f;
#pragma unroll
    for (int e = 0; e < 16; ++e) { sa += va[e] * va[e]; sb += vb[e] * vb[e]; }
    const float ra = 1.f / sqrtf(wave_sum(sa, lane) * (1.f / 1024.f) + 1e-6f), rb = 1.f / sqrtf(wave_sum(sb, lane) * (1.f / 1024.f) + 1e-6f);
    const float gg[16] = {g0[0], g0[1], g0[2], g0[3], g1[0], g1[1], g1[2], g1[3], g2[0], g2[1], g2[2], g2[3], g3[0], g3[1], g3[2], g3[3]};
    u32x4 oa0, oa1, ob0, ob1;
    oa0.x = pk2(va[0] * ra * gg[0], va[1] * ra * gg[1]); oa0.y = pk2(va[2] * ra * gg[2], va[3] * ra * gg[3]); oa0.z = pk2(va[4] * ra * gg[4], va[5] * ra * gg[5]); oa0.w = pk2(va[6] * ra * gg[6], va[7] * ra * gg[7]);
    oa1.x = pk2(va[8] * ra * gg[8], va[9] * ra * gg[9]); oa1.y = pk2(va[10] * ra * gg[10], va[11] * ra * gg[11]); oa1.z = pk2(va[12] * ra * gg[12], va[13] * ra * gg[13]); oa1.w = pk2(va[14] * ra * gg[14], va[15] * ra * gg[15]);
    ob0.x = pk2(vb[0] * rb * gg[0], vb[1] * rb * gg[1]); ob0.y = pk2(vb[2] * rb * gg[2], vb[3] * rb * gg[3]); ob0.z = pk2(vb[4] * rb * gg[4], vb[5] * rb * gg[5]); ob0.w = pk2(vb[6] * rb * gg[6], vb[7] * rb * gg[7]);
    ob1.x = pk2(vb[8] * rb * gg[8], vb[9] * rb * gg[9]); ob1.y = pk2(vb[10] * rb * gg[10], vb[11] * rb * gg[11]); ob1.z = pk2(vb[12] * rb * gg[12], vb[13] * rb * gg[13]); ob1.w = pk2(vb[14] * rb * gg[14], vb[15] * rb * gg[15]);
    *((u32x4*)(H2 + (size_t)m * D_) + lane) = oa0; *((u32x4*)(H2 + (size_t)m * D_) + 64 + lane) = oa1;
    *((u32x4*)(H2 + (size_t)m2 * D_) + lane) = ob0; *((u32x4*)(H2 + (size_t)m2 * D_) + 64 + lane) = ob1; }
}
#define GEMM_PHASE(EpiT, Aptr, Bptr, Nn, Kk, ...) do { pg8::Gemm g_{(const bf16_t*)(Aptr), (const bf16_t*)(Bptr), T_, (Nn), (Kk), wv}; pg8::StaticOrder S_; S_.init(T_, (Nn), (int)gridDim.x, (int)blockIdx.x); \
    EpiT E_{__VA_ARGS__}; pg8::gemm_phase<EpiT, pg8::StaticOrder, PG8_ALIGN, PG8_SP2>((PG8_LAS unsigned char*)lds, g_, S_, E_); } while (0)
#ifndef REP_P0
#define REP_P0 1
#endif
#ifndef REP_ATTN
#define REP_ATTN 1
#endif
#ifndef REP_CP
#define REP_CP 1
#endif
#ifndef REP_SCAN
#define REP_SCAN 1
#endif
#ifndef REP_EW
#define REP_EW 1
#endif
#ifndef REP_GEMM
#define REP_GEMM 1
#endif
#define XB_TMO      128
#define XB_XCNT(j)  (256  + 64 * (j))
#define XB_XSUB(j)  (1280 + 64 * (j))
#define XB_XGEN(j)  (2304 + 64 * (j))
#define XB_TOP      3328
#define XB_TOPGEN   3392
#define XCD_BAR_WORDS 3456
#define XB_SPIN_CAP (1u << 18)

__device__ __forceinline__ unsigned xb_ld(unsigned* p)              { return __hip_atomic_load(p, __ATOMIC_RELAXED, __HIP_MEMORY_SCOPE_AGENT); }
__device__ __forceinline__ unsigned xb_add(unsigned* p, unsigned v) { return __hip_atomic_fetch_add(p, v, __ATOMIC_RELAXED, __HIP_MEMORY_SCOPE_AGENT); }
__device__ __forceinline__ unsigned xb_xcc_id() { return (unsigned)__builtin_amdgcn_s_getreg((3 << 11) | 20) & 0xFu; }
#define XB_SPIN(cond, bar) do { unsigned _sp = 0; while (cond) { __builtin_amdgcn_s_sleep(1); \
    if ((++_sp & 255u) == 0u) { if (xb_ld(&(bar)[XB_TMO])) break; if (_sp > XB_SPIN_CAP) { atomicAdd(&(bar)[XB_TMO], 1u); break; } } } } while (0)

struct XcdBarrier {
    int wv;
    unsigned* bar; unsigned x;
    volatile LAS unsigned* st;
};

__device__ __forceinline__ XcdBarrier xcd_barrier_post(unsigned* bar, volatile LAS unsigned* st) {
    XcdBarrier b; b.bar = bar; b.x = xb_xcc_id(); b.st = st; b.wv = 0;
    if (threadIdx.x == 0) (void)xb_add(&bar[XB_XCNT(b.x)], 1u);
    return b;
}
__device__ __forceinline__ void xcd_barrier_complete(unsigned* bar, unsigned x, unsigned& nloc, unsigned& nx) {
    const unsigned G = gridDim.x * gridDim.y * gridDim.z;
    unsigned sum, cnt, mine, sp = 0u;
    for (;;) {
        sum = 0u; cnt = 0u; mine = 0u;
#pragma unroll
        for (unsigned j = 0; j < 16; ++j) { const unsigned c = xb_ld(&bar[XB_XCNT(j)]); sum += c; cnt += (c > 0u) ? 1u : 0u; mine = (j == x) ? c : mine; }
        if (sum == G) break;
        __builtin_amdgcn_s_sleep(1);
        if ((++sp & 255u) == 0u) { if (xb_ld(&bar[XB_TMO])) break; if (sp > XB_SPIN_CAP) { atomicAdd(&bar[XB_TMO], 1u); break; } }
    }
    nloc = mine > 0u ? mine : 1u; nx = cnt > 0u ? cnt : 1u;
}

__device__ __forceinline__ void xcd_barrier(const XcdBarrier& b) {
    asm volatile("s_waitcnt vmcnt(0)" ::: "memory");
    __syncthreads();
    if (b.wv == 0 && lane_id() == 0) {
        unsigned* bar = b.bar;
        __builtin_amdgcn_s_waitcnt(0);
        unsigned nloc = b.st[0], nx = b.st[1];
        if (nloc == 0u) { xcd_barrier_complete(bar, b.x, nloc, nx); b.st[0] = nloc; b.st[1] = nx; }
        const unsigned old = xb_add(&bar[XB_XSUB(b.x)], 1u);
        const unsigned gen = old / nloc;
        if (old + 1u == (gen + 1u) * nloc) {
            __builtin_amdgcn_fence(__ATOMIC_RELEASE, "agent");
            asm volatile("s_waitcnt vmcnt(0)" ::: "memory");
            const unsigned og = xb_add(&bar[XB_TOP], 1u);
            const unsigned tg = og / nx;
            if (og + 1u == (tg + 1u) * nx) xb_add(&bar[XB_TOPGEN], 1u);
            else XB_SPIN(xb_ld(&bar[XB_TOPGEN]) == tg, bar);
            __builtin_amdgcn_fence(__ATOMIC_ACQUIRE, "agent");
            xb_add(&bar[XB_XGEN(b.x)], 1u);
            asm volatile("s_waitcnt vmcnt(0)" ::: "memory");
        } else {
            XB_SPIN(xb_ld(&bar[XB_XGEN(b.x)]) == gen, bar);
            __builtin_amdgcn_fence(__ATOMIC_ACQUIRE, "agent");
            asm volatile("s_waitcnt vmcnt(0)" ::: "memory");
        }
    }
    __syncthreads();
}

constexpr size_t WS_BAR = 51 * MiB; constexpr int LDS_ST_OFF = 159744 - 256;
typedef const __attribute__((address_space(4))) Params* kparams_t;
DI Params load_params() {
  Params r{};
#if defined(__HIP_DEVICE_COMPILE__)
  kparams_t k = (kparams_t)__builtin_amdgcn_kernarg_segment_ptr(); asm volatile("" : "+s"(k));
  r.x = k->x; r.norm1_w = k->norm1_w; r.w_in = k->w_in; r.conv_w = k->conv_w; r.a_log = k->a_log; r.dt_bias = k->dt_bias; r.dn_norm_w = k->dn_norm_w; r.w_proj_a = k->w_proj_a;
  r.w_proj_b = k->w_proj_b; r.w_out = k->w_out; r.norm2_w = k->norm2_w; r.w_gate_up = k->w_gate_up; r.w_down = k->w_down; r.final_norm_w = k->final_norm_w; r.out = k->out; r.ws = k->ws;
#endif
  return r;
}
#define WSP (p.ws)
#define OBP ((unsigned char*)p.out)
#define WINP ((bf16_t*)(p.ws + WS_WIN))
__global__ void __launch_bounds__(512, 2) fwd_megakernel(Params p_unused) {
  extern __shared__ __attribute__((aligned(16))) unsigned char lds_raw[];
  cg::grid_group grid = cg::this_grid();
  lds_t lds = (lds_t)lds_raw;
  volatile LAS unsigned* st = (volatile LAS unsigned*)(lds + LDS_ST_OFF);
  if (threadIdx.x < 4) st[threadIdx.x] = 0u;
  __syncthreads();
  int wv = __builtin_amdgcn_readfirstlane((int)threadIdx.x >> 6); asm volatile("" : "+s"(wv));
  XcdBarrier bar;
  { const Params p = load_params(); bar = xcd_barrier_post((unsigned*)(p.ws + WS_BAR), st); bar.wv = wv; }
  { const Params p = load_params(); p0_prologue(p, lds, wv); } if (REP_P0 > 1) { const Params p = load_params(); p0_prologue(p, lds, wv); }
  if (wv < 0) grid.sync();
  xcd_barrier(bar);
  { const Params p = load_params(); GEMM_PHASE(EpiRope, OBP + DO_H1, WINP, 4608, 1024, (bf16_t*)(WSP + WS_AQKV), (const float*)(WSP + WS_ROPE)); }
#ifdef REP_G1
  { const Params p = load_params(); GEMM_PHASE(EpiRope, OBP + DO_H1, WINP, 4608, 1024, (bf16_t*)(WSP + WS_AQKV), (const float*)(WSP + WS_ROPE)); }
#endif
  xcd_barrier(bar);
  { const Params p = load_params(); attn_phase(p, lds, wv); } if (REP_ATTN > 1) { const Params p = load_params(); attn_phase(p, lds, wv); }
  xcd_barrier(bar);
  { const Params p = load_params(); combine_phase(p, wv); } if (REP_EW > 1) { const Params p = load_params(); combine_phase(p, wv); }
  { const Params p = load_params(); bg_phase(p, wv); }
  __syncthreads();
  { const Params p = load_params(); GEMM_PHASE(EpiDn, OBP + DO_H1, WINP + (size_t)4608 * 1024, 3072, 1024, (bf16_t*)(WSP + WS_DQKV), (float*)(WSP + WS_BG)); }
  xcd_barrier(bar);
  { const Params p = load_params(); chunkprep_wave(p, lds, wv); } if (REP_CP > 1) { const Params p = load_params(); chunkprep_wave(p, lds, wv); }
  xcd_barrier(bar);
  if (REP_SCAN > 1) { const Params p = load_params(); scan_phase<0>(p, lds, wv); }
  { const Params p = load_params(); scan_phase<1>(p, lds, wv); }
  xcd_barrier(bar);
  { const Params p = load_params(); GEMM_PHASE(EpiZG, OBP + DO_H1, WINP + (size_t)7936 * 1024, 3072, 1024, (bf16_t*)(WSP + WS_ZG)); }
  xcd_barrier(bar);
  { const Params p = load_params(); gate_phase(p, wv); } if (REP_EW > 1) { const Params p = load_params(); gate_phase(p, wv); }
  xcd_barrier(bar);
  { const Params p = load_params(); GEMM_PHASE(EpiYa, WSP + WS_OA, WSP + WS_WPA, 1024, 1024, (bf16_t*)(WSP + WS_PART), (const bf16_t*)(WSP + WS_ZG)); }
  { const Params p = load_params(); GEMM_PHASE(EpiYb, OBP + DO_OB, WSP + WS_WPB, 1024, 512, (const bf16_t*)(WSP + WS_PART), (const bf16_t*)(WSP + WS_ZG), (bf16_t*)(WSP + WS_MERGED)); }
  xcd_barrier(bar);
  { const Params p = load_params(); GEMM_PHASE(EpiResToB, WSP + WS_MERGED, WSP + WS_WOUT, 1024, 1024, p.x, (bf16_t*)(WSP + WS_X1)); }
#ifdef REP_G9
  { const Params p = load_params(); GEMM_PHASE(EpiResToB, WSP + WS_MERGED, WSP + WS_WOUT, 1024, 1024, p.x, (bf16_t*)(WSP + WS_X1)); }
#endif
  xcd_barrier(bar);
  { const Params p = load_params(); norm2_phase(p, wv); } if (REP_EW > 1) { const Params p = load_params(); norm2_phase(p, wv); }
  xcd_barrier(bar);
  { const Params p = load_params(); GEMM_PHASE(EpiSwiglu, WSP + WS_H2, WSP + WS_WGU, 5632, 1024, (bf16_t*)(WSP + WS_ACT)); } if (REP_GEMM > 1) { const Params p = load_params(); GEMM_PHASE(EpiSwiglu, WSP + WS_H2, WSP + WS_WGU, 5632, 1024, (bf16_t*)(WSP + WS_ACT)); }
  xcd_barrier(bar);
  { const Params p = load_params(); GEMM_PHASE(EpiResBB, WSP + WS_ACT, WSP + WS_WDN, 1024, FF_, (const bf16_t*)(WSP + WS_X1), (bf16_t*)(WSP + WS_X2B)); }
#ifdef REP_G12
  { const Params p = load_params(); GEMM_PHASE(EpiResBB, WSP + WS_ACT, WSP + WS_WDN, 1024, FF_, (const bf16_t*)(WSP + WS_X1), (bf16_t*)(WSP + WS_X2B)); }
#endif
  xcd_barrier(bar);
  { const Params p = load_params(); final_norm_phase(p, wv); }
}

extern "C" void kernel_launch(void* const* d_in, const int* in_sizes, int n_in, void* d_out, int out_size, void* d_ws, size_t ws_size, hipStream_t stream) {
  static int grid_blocks = 0;
  if (grid_blocks == 0) {
    if (n_in != 14 || out_size != T_ * D_ || ws_size < 8 * U_) { fprintf(stderr, "kernel_launch: unexpected shapes n_in %d out %d ws %zu\n", n_in, out_size, ws_size); grid_blocks = -1; return; }
    int dev = 0, cus = 0, per_cu = 0;
    (void)hipGetDevice(&dev); (void)hipDeviceGetAttribute(&cus, hipDeviceAttributeMultiprocessorCount, dev);
    if (hipFuncSetAttribute((const void*)fwd_megakernel, hipFuncAttributeMaxDynamicSharedMemorySize, LDS_BYTES) != hipSuccess) { fprintf(stderr, "hipFuncSetAttribute failed\n"); grid_blocks = -1; return; }
    if (hipOccupancyMaxActiveBlocksPerMultiprocessor(&per_cu, (const void*)fwd_megakernel, 512, LDS_BYTES) != hipSuccess || per_cu < 1) { fprintf(stderr, "occupancy query failed (%d)\n", per_cu); per_cu = 1; }
    (void)hipGetLastError();
    grid_blocks = cus * per_cu;
  }
  if (grid_blocks < 0) return;
  if (hipMemsetAsync((unsigned char*)d_ws + WS_BAR, 0, 16384, stream) != hipSuccess) { fprintf(stderr, "memset failed\n"); return; }
  Params p{};
  p.x = (const float*)d_in[0]; p.norm1_w = (const float*)d_in[1]; p.w_in = (const float*)d_in[2]; p.conv_w = (const float*)d_in[3]; p.a_log = (const float*)d_in[4];
  p.dt_bias = (const float*)d_in[5]; p.dn_norm_w = (const float*)d_in[6]; p.w_proj_a = (const float*)d_in[7]; p.w_proj_b = (const float*)d_in[8]; p.w_out = (const float*)d_in[9];
  p.norm2_w = (const float*)d_in[10]; p.w_gate_up = (const float*)d_in[11]; p.w_down = (const float*)d_in[12]; p.final_norm_w = (const float*)d_in[13];
  p.out = (float*)d_out; p.ws = (unsigned char*)d_ws;
  void* args[] = {&p};
  hipError_t e = hipLaunchCooperativeKernel((const void*)fwd_megakernel, dim3(grid_blocks), dim3(512), args, LDS_BYTES, stream);
  if (e != hipSuccess) fprintf(stderr, "cooperative launch failed: %s (grid %d)\n", hipGetErrorString(e), grid_blocks);
}
```

```cpp
#include <hip/hip_runtime.h>
#include <hip/hip_cooperative_groups.h>
#include <cstdio>
#include <cstdint>
namespace cg = cooperative_groups;
namespace pg8 {
#define PG8_LAS __attribute__((address_space(3)))
typedef unsigned short bf16_t;
typedef short bf16x8 __attribute__((ext_vector_type(8)));
typedef float f32x4 __attribute__((ext_vector_type(4)));
typedef unsigned u32x4 __attribute__((ext_vector_type(4)));
constexpr int BM = 256, BK = 64, HALF = 128, HTB = HALF * BK * 2  , STAGE_BYTES = 8 * HTB, NXCD = 8, WGM = 8;

__host__ __device__ __forceinline__ int lds_byte(int r, int c) { const int st = (r >> 4) * 2 + (c >> 5), rr = r & 15, cc = c & 31, ob = rr * 64 + cc * 2; return st * 1024 + (ob ^ (((ob >> 9) & 1) << 5)); }
__host__ __device__ __forceinline__ void stage_rc(int b, int& R, int& C) { const int st = b / 1024, sb = b % 1024, swz = sb ^ (((sb >> 9) & 1) << 5); R = (st >> 1) * 16 + swz / 64; C = (st & 1) * 32 + (swz % 64) / 2; }
__host__ __device__ __forceinline__ int perm32(int rho) { const int n = rho >> 4, i = rho & 15; return 8 * (i >> 2) + 4 * n + (i & 3); }

struct Unit { int pm, pn; };
struct Gemm { const bf16_t* A; const bf16_t* Bt; int M, N, K, wv; };

struct StaticOrder {
    int nM, nN, nwg, G, c;
    __host__ __device__ void init(int M, int N, int G_, int c_) { nM = M / BM; nN = N / BM; nwg = nM * nN; G = G_; c = c_; }
    __host__ __device__ bool next(int i, Unit& u) const {
        const long L = (long)i * G + c; if (L >= nwg) return false;
        int wgid = (int)L; { const int q = nwg / NXCD, r = nwg % NXCD, xcd = wgid % NXCD, off = wgid / NXCD; wgid = (xcd < r ? xcd * (q + 1) : r * (q + 1) + (xcd - r) * q) + off; }
        const int nig = WGM * nN, gid = wgid / nig, fm = gid * WGM, gsz = (nM - fm) < WGM ? (nM - fm) : WGM;
        u.pm = fm + ((wgid % nig) % gsz); u.pn = (wgid % nig) / gsz; return true;
    }
    __device__ __forceinline__ void a_ready(const Unit&) const {}
    __device__ __forceinline__ void done(const Unit&) const {}
};

template <class Epi, class Sched, bool ALIGN_EPI = false, bool SP2 = false>
__device__ __forceinline__ void gemm_phase(PG8_LAS unsigned char* lds, const Gemm g, const Sched& S, const Epi& E) {
    int ln_; asm volatile("v_mbcnt_lo_u32_b32 %0, -1, 0\n\tv_mbcnt_hi_u32_b32 %0, -1, %0" : "=v"(ln_)); int tid_ = (g.wv << 6) | ln_; const int tid = tid_, wid = __builtin_amdgcn_readfirstlane(tid >> 6), lane = tid & 63, wr = wid >> 2, wc = wid & 3, fr = lane & 15, fq = lane >> 4;
    const int K = g.K, nt = K / BK;
    unsigned voffA[2], voffB[2];
#pragma unroll
    for (int i = 0; i < 2; ++i) { int R, C; stage_rc(tid * 16 + i * 8192, R, C); const int Rb = Epi::PERM ? ((R & ~31) + perm32(R & 31)) : R;
        voffA[i] = (unsigned)(R * K + C) * 2u; voffB[i] = (unsigned)(Rb * K + C) * 2u; }
    const size_t kstep = (size_t)(BK * 2);
    const size_t hstep = (size_t)HALF * K * 2;
    const size_t tstep = 2 * hstep;
    const unsigned ldsw = (unsigned)wid * 1024u;
    const int aoff = lds_byte(wr * 64 + fr, fq * 8), boff = lds_byte(wc * 32 + fr, fq * 8);
#define PG8_SA(b, h) (((b) * 2 + (h)) * HTB)
#define PG8_SB(b, h) ((4 + (b) * 2 + (h)) * HTB)
#define PG8_STAGE(bufoff, gbase, voff) do { _Pragma("unroll") for (int _i = 0; _i < 2; ++_i) \
        __builtin_amdgcn_global_load_lds((const unsigned*)((const char*)(gbase) + (voff)[_i]), (PG8_LAS unsigned*)(lds + (bufoff) + ldsw + _i * 8192), 16, 0, 0); } while (0)
#define PG8_LDA(dst, b, h) do { _Pragma("unroll") for (int m = 0; m < 4; ++m) _Pragma("unroll") for (int k = 0; k < 2; ++k) dst[m][k] = *(const PG8_LAS bf16x8*)(lds + PG8_SA(b, h) + aoff + m * 2048 + k * 1024); } while (0)
#define PG8_LDB(dst, b, h) do { _Pragma("unroll") for (int n = 0; n < 2; ++n) _Pragma("unroll") for (int k = 0; k < 2; ++k) dst[n][k] = *(const PG8_LAS bf16x8*)(lds + PG8_SB(b, h) + boff + n * 2048 + k * 1024); } while (0)
#define PG8_MMA(ai, bj, At, Bt) do { __builtin_amdgcn_s_setprio(1); _Pragma("unroll") for (int m = 0; m < 4; ++m) _Pragma("unroll") for (int n = 0; n < 2; ++n) _Pragma("unroll") for (int k = 0; k < 2; ++k) \
        acc[ai][bj][m][n] = __builtin_amdgcn_mfma_f32_16x16x32_bf16(Bt[n][k], At[m][k], acc[ai][bj][m][n], 0, 0, 0); __builtin_amdgcn_s_setprio(0); } while (0)
#define PG8_WAIT_V(n) asm volatile("s_waitcnt vmcnt(" #n ")" ::: "memory")
#define PG8_WAIT_L(n) asm volatile("s_waitcnt lgkmcnt(" #n ")" ::: "memory")
#define PG8_BAR __builtin_amdgcn_s_barrier()
#define PG8_SCHED __builtin_amdgcn_sched_barrier(0)
    Unit cur, nxt; int ui = 0;
    if (!S.next(0, cur)) return;
    f32x4 acc[2][2][4][2];
#pragma unroll
    for (int a = 0; a < 2; ++a)
#pragma unroll
        for (int b = 0; b < 2; ++b)
#pragma unroll
            for (int m = 0; m < 4; ++m)
#pragma unroll
                for (int n = 0; n < 2; ++n) acc[a][b][m][n] = (f32x4){0.f, 0.f, 0.f, 0.f};
    bf16x8 At[4][2], B0[2][2], B1[2][2];
    const char* cA = (const char*)g.A + (size_t)cur.pm * tstep; const char* cB = (const char*)g.Bt + (size_t)cur.pn * tstep;
    S.a_ready(cur);
    if constexpr (SP2) {
        PG8_STAGE(PG8_SB(0, 0), cB, voffB); PG8_STAGE(PG8_SB(0, 1), cB + hstep, voffB); PG8_STAGE(PG8_SA(0, 0), cA, voffA); PG8_STAGE(PG8_SA(0, 1), cA + hstep, voffA);
        if (wr == 1) PG8_BAR;
        PG8_WAIT_V(2); PG8_BAR;
        PG8_STAGE(PG8_SB(1, 0), cB + kstep, voffB); PG8_STAGE(PG8_SA(1, 0), cA + kstep, voffA); PG8_STAGE(PG8_SB(1, 1), cB + hstep + kstep, voffB);
        PG8_WAIT_V(6); PG8_BAR;
    } else {
        PG8_STAGE(PG8_SB(0, 0), cB, voffB); PG8_STAGE(PG8_SA(0, 0), cA, voffA); PG8_STAGE(PG8_SB(0, 1), cB + hstep, voffB); PG8_STAGE(PG8_SA(0, 1), cA + hstep, voffA);
        if (wr == 1) PG8_BAR;
        PG8_WAIT_V(4); PG8_BAR;
        PG8_STAGE(PG8_SB(1, 0), cB + kstep, voffB); PG8_STAGE(PG8_SA(1, 0), cA + kstep, voffA); PG8_STAGE(PG8_SB(1, 1), cB + hstep + kstep, voffB);
        PG8_WAIT_V(6); PG8_BAR;
    }
    for (;;) {
        const bool has_next = S.next(ui + 1, nxt);
        const char* nA = has_next ? (const char*)g.A + (size_t)nxt.pm * tstep : cA; const char* nB = has_next ? (const char*)g.Bt + (size_t)nxt.pn * tstep : cB;
        for (int t = 0; t < nt; t += 2) {
            const bool last = (t == nt - 2);
            const char* a1 = cA + (size_t)(t + 1) * kstep;
            const char* a2 = last ? nA : cA + (size_t)(t + 2) * kstep; const char* b2 = last ? nB : cB + (size_t)(t + 2) * kstep;
            const char* a3 = a2 + kstep; const char* b3 = b2 + kstep;
            if (last && has_next) S.a_ready(nxt);
            if constexpr (SP2) {
            PG8_LDB(B0, 0, 0); PG8_LDB(B1, 0, 1); PG8_SCHED; PG8_LDA(At, 0, 0); PG8_STAGE(PG8_SA(1, 1), a1 + hstep, voffA);
            PG8_WAIT_V(8); PG8_WAIT_L(0); PG8_BAR; PG8_MMA(0, 0, At, B0); PG8_MMA(0, 1, At, B1); PG8_BAR; PG8_SCHED;
            PG8_LDA(At, 0, 1); PG8_STAGE(PG8_SB(0, 0), b2, voffB); PG8_STAGE(PG8_SB(0, 1), b2 + hstep, voffB); PG8_STAGE(PG8_SA(0, 0), a2, voffA);
            PG8_WAIT_V(8); PG8_WAIT_L(0); PG8_BAR; PG8_MMA(1, 0, At, B0); PG8_MMA(1, 1, At, B1); PG8_BAR; PG8_SCHED;
            PG8_LDB(B0, 1, 0); PG8_LDB(B1, 1, 1); PG8_SCHED; PG8_LDA(At, 1, 0); PG8_STAGE(PG8_SA(0, 1), a2 + hstep, voffA);
            PG8_WAIT_V(8); PG8_WAIT_L(0); PG8_BAR; PG8_MMA(0, 0, At, B0); PG8_MMA(0, 1, At, B1); PG8_BAR; PG8_SCHED;
            PG8_LDA(At, 1, 1); PG8_STAGE(PG8_SB(1, 0), b3, voffB); PG8_STAGE(PG8_SB(1, 1), b3 + hstep, voffB); PG8_STAGE(PG8_SA(1, 0), a3, voffA);
            PG8_WAIT_V(8); PG8_WAIT_L(0); PG8_BAR; PG8_MMA(1, 0, At, B0); PG8_MMA(1, 1, At, B1); PG8_BAR; PG8_SCHED;
            } else {
            PG8_LDB(B0, 0, 0); PG8_SCHED; PG8_LDA(At, 0, 0); PG8_STAGE(PG8_SA(1, 1), a1 + hstep, voffA);
            PG8_WAIT_L(8); PG8_BAR; PG8_WAIT_L(0); PG8_MMA(0, 0, At, B0); PG8_BAR; PG8_SCHED;
            PG8_LDB(B1, 0, 1); PG8_STAGE(PG8_SB(0, 0), b2, voffB);
            PG8_BAR; PG8_WAIT_L(0); PG8_MMA(0, 1, At, B1); PG8_BAR;
            PG8_LDA(At, 0, 1); PG8_STAGE(PG8_SA(0, 0), a2, voffA);
            PG8_BAR; PG8_WAIT_L(0); PG8_MMA(1, 0, At, B0); PG8_BAR; PG8_SCHED;
            PG8_STAGE(PG8_SB(0, 1), b2 + hstep, voffB);
            PG8_WAIT_V(6); PG8_BAR; PG8_MMA(1, 1, At, B1); PG8_BAR;
            PG8_LDB(B0, 1, 0); PG8_SCHED; PG8_LDA(At, 1, 0); PG8_STAGE(PG8_SA(0, 1), a2 + hstep, voffA);
            PG8_WAIT_L(8); PG8_BAR; PG8_WAIT_L(0); PG8_MMA(0, 0, At, B0); PG8_BAR; PG8_SCHED;
            PG8_LDB(B1, 1, 1); PG8_STAGE(PG8_SB(1, 0), b3, voffB);
            PG8_BAR; PG8_WAIT_L(0); PG8_MMA(0, 1, At, B1); PG8_BAR;
            PG8_LDA(At, 1, 1); PG8_STAGE(PG8_SA(1, 0), a3, voffA);
            PG8_BAR; PG8_WAIT_L(0); PG8_MMA(1, 0, At, B0); PG8_BAR; PG8_SCHED;
            PG8_STAGE(PG8_SB(1, 1), b3 + hstep, voffB);
            PG8_WAIT_V(6); PG8_BAR; PG8_MMA(1, 1, At, B1); PG8_BAR;
            }
        }
        if constexpr (ALIGN_EPI) { if (wr == 0) PG8_BAR; }
        if constexpr (!Epi::AFTER_DRAIN) { E(acc, cur, wr, wc, fr, fq); S.done(cur); }
        if (!has_next) break;
#pragma unroll
        for (int a = 0; a < 2; ++a)
#pragma unroll
            for (int b = 0; b < 2; ++b)
#pragma unroll
                for (int m = 0; m < 4; ++m)
#pragma unroll
                    for (int n = 0; n < 2; ++n) acc[a][b][m][n] = (f32x4){0.f, 0.f, 0.f, 0.f};
        cur = nxt; cA = nA; cB = nB; ++ui;
        if constexpr (ALIGN_EPI) { if (wr == 1) PG8_BAR; }
    }
    PG8_WAIT_V(0);
    if constexpr (!ALIGN_EPI) { if (wr == 0) PG8_BAR; }
    PG8_BAR;
    if constexpr (Epi::AFTER_DRAIN) { E.fused(acc, cur, wr, wc, fr, fq, lds, wid, lane); S.done(cur); }
#undef PG8_SA
#undef PG8_SB
#undef PG8_STAGE
#undef PG8_LDA
#undef PG8_LDB
#undef PG8_MMA
#undef PG8_WAIT_V
#undef PG8_WAIT_L
#undef PG8_BAR
#undef PG8_SCHED
}
}

#ifndef PG8_SP2
#define PG8_SP2 true
#endif
#ifndef PG8_ALIGN
#define PG8_ALIGN true
#endif
#define DI __device__ __forceinline__
#define LAS __attribute__((address_space(3)))
typedef LAS unsigned char* lds_t;
typedef unsigned short bf16_t;
typedef short bf16x8 __attribute__((ext_vector_type(8)));
typedef short s16x4 __attribute__((ext_vector_type(4)));
typedef short v4i16_t __attribute__((ext_vector_type(4)));
typedef float f32x4 __attribute__((ext_vector_type(4)));
typedef float f32x2 __attribute__((ext_vector_type(2)));
typedef unsigned u32x4 __attribute__((ext_vector_type(4)));
typedef unsigned u32x2 __attribute__((ext_vector_type(2)));

constexpr int T_ = 32768, L_ = 4096, D_ = 1024, IN_ = 10768, FF_ = 2816;
constexpr size_t MiB = 1u << 20;
constexpr size_t WS_WIN = 0, WS_WPA = 22 * MiB, WS_WPB = 24 * MiB, WS_WOUT = 25 * MiB, WS_WGU = 27 * MiB, WS_WDN = 38 * MiB;
constexpr size_t WS_ROPE = 44 * MiB, WS_BG = 45 * MiB, WS_LSE = 48 * MiB, WS_GL = 50 * MiB;
constexpr size_t U_ = 64 * MiB;
constexpr size_t S1 = 1 * U_, S2 = 2 * U_, S3 = 3 * U_, S4 = 4 * U_, S5 = 5 * U_, S6 = 6 * U_, S7 = 7 * U_;
constexpr size_t WS_AQKV = S1;
constexpr size_t WS_OG = S1 + 9 * U_ / 2;
constexpr size_t WS_DQKV = S1;
constexpr size_t WS_QD = S4, WS_KDT = S5, WS_U = S6, WS_W = S7;
constexpr size_t WS_ORAW = S1;
constexpr size_t WS_ZG = S4;
constexpr size_t WS_OA = S7;
constexpr size_t WS_PART = S1;
constexpr size_t WS_MERGED = S3;
constexpr size_t WS_X1 = S4;
constexpr size_t WS_H2 = S6;
constexpr size_t WS_ACT = S1;
constexpr size_t DO_H1 = 0, DO_OB = U_, DO_QK = U_ + U_ / 2;
constexpr int LDS_BYTES = 159744;

struct Params {
  const float *x, *norm1_w, *w_in, *conv_w, *a_log, *dt_bias, *dn_norm_w, *w_proj_a, *w_proj_b, *w_out, *norm2_w, *w_gate_up, *w_down, *final_norm_w;
  float* out; unsigned char* ws;
};

DI int lane_id() { int l; asm volatile("v_mbcnt_lo_u32_b32 %0, -1, 0\n\tv_mbcnt_hi_u32_b32 %0, -1, %0" : "=v"(l)); return l; }
#define TIDS() const int wave = wv, lane = lane_id(), tid = (wv << 6) | lane; (void)lane; (void)wave; (void)tid
typedef __bf16 bf16v2_t __attribute__((ext_vector_type(2)));
DI unsigned pk2(float lo, float hi) { const f32x2 v = {lo, hi}; return __builtin_bit_cast(unsigned, __builtin_convertvector(v, bf16v2_t)); }
DI unsigned f2bf(float f) { return pk2(f, 0.f) & 0xffffu; }
DI float bf2f(unsigned h) { return __builtin_bit_cast(float, h << 16); }
DI float bflo(unsigned w) { return __builtin_bit_cast(float, w << 16); }
DI float bfhi(unsigned w) { return __builtin_bit_cast(float, w & 0xffff0000u); }
#define BPERM(srcl, v) __shfl((v), (srcl))
template <int M> DI float shx(float v, int lane) { return BPERM(lane ^ M, v); }
DI float wave_sum(float v, int lane) { v += shx<1>(v, lane); v += shx<2>(v, lane); v += shx<4>(v, lane); v += shx<8>(v, lane); v += shx<16>(v, lane); v += shx<32>(v, lane); return v; }
DI float sum16(float v, int lane) { v += shx<1>(v, lane); v += shx<2>(v, lane); v += shx<4>(v, lane); v += shx<8>(v, lane); return v; }
DI float max16(float v, int lane) { v = fmaxf(v, shx<1>(v, lane)); v = fmaxf(v, shx<2>(v, lane)); v = fmaxf(v, shx<4>(v, lane)); v = fmaxf(v, shx<8>(v, lane)); return v; }
DI float sigmoidf_(float x) { return __builtin_amdgcn_rcpf(1.f + __expf(-x)); }
DI float siluf_(float x) { return x * __builtin_amdgcn_rcpf(1.f + __expf(-x)); }
DI s16x4 lds_tr(lds_t p) { return __builtin_bit_cast(s16x4, __builtin_amdgcn_ds_read_tr16_b64_v4i16((LAS v4i16_t*)p)); }
DI bf16x8 lds_ld16(lds_t p) { return *(LAS bf16x8*)p; }
#define MFMA16(a, b, c) __builtin_amdgcn_mfma_f32_16x16x32_bf16((a), (b), (c), 0, 0, 0)

using pg8::Unit;
DI unsigned cvt_pk_bf16(float lo, float hi) { return pk2(lo, hi); }
DI u32x4 pack8(f32x4 v0, f32x4 v1) { u32x4 w; w.x = cvt_pk_bf16(v0[0], v0[1]); w.y = cvt_pk_bf16(v0[2], v0[3]); w.z = cvt_pk_bf16(v1[0], v1[1]); w.w = cvt_pk_bf16(v1[2], v1[3]); return w; }

struct EpiRope {
  static constexpr bool PERM = true, AFTER_DRAIN = false;
  bf16_t* O; const float* rope;
  DI void operator()(const f32x4 (&acc)[2][2][4][2], const Unit& u, int wr, int wc, int fr, int fq) const {
    const int row0 = u.pm * 256 + wr * 64 + fr;
#pragma unroll
    for (int bj = 0; bj < 2; ++bj) {
      const int colb = u.pn * 256 + 128 * bj; const bool dorope = (colb < 3072) && (wc == 0);
#pragma unroll
      for (int ai = 0; ai < 2; ++ai)
#pragma unroll
        for (int m = 0; m < 4; ++m) {
          const int row = row0 + ai * 128 + m * 16; f32x4 v0 = acc[ai][bj][m][0], v1 = acc[ai][bj][m][1];
          if (dorope) {
            const int pos = row & (L_ - 1); const float* rp = rope + ((size_t)pos * 16 + 8 * (fq & 1)) * 2;
            f32x4 p0, p1;
#pragma unroll
            for (int e = 0; e < 4; ++e) { p0[e] = BPERM((fq * 16 + fr) ^ 32, v0[e]); p1[e] = BPERM((fq * 16 + fr) ^ 32, v1[e]); }
            const f32x4 c0 = *(const f32x4*)(rp), c1 = *(const f32x4*)(rp + 4), c2 = *(const f32x4*)(rp + 8), c3 = *(const f32x4*)(rp + 12);
            const float cs[8] = {c0[0], c0[2], c1[0], c1[2], c2[0], c2[2], c3[0], c3[2]}, sn[8] = {c0[1], c0[3], c1[1], c1[3], c2[1], c2[3], c3[1], c3[3]};
            const float sg = (fq < 2) ? -1.f : 1.f;
#pragma unroll
            for (int e = 0; e < 4; ++e) { v0[e] = v0[e] * cs[e] + sg * p0[e] * sn[e]; v1[e] = v1[e] * cs[4 + e] + sg * p1[e] * sn[4 + e]; }
          }
          *(u32x4*)(O + (size_t)row * 4608 + colb + wc * 32 + 8 * fq) = pack8(v0, v1);
        }
    }
  }
};
struct EpiDn {
  static constexpr bool PERM = true, AFTER_DRAIN = false;
  bf16_t* O; float* BG;
  DI void operator()(const f32x4 (&acc)[2][2][4][2], const Unit& u, int wr, int wc, int fr, int fq) const {
    const int row0 = u.pm * 256 + wr * 64 + fr;
    if (u.pn < 12) {
#pragma unroll
      for (int ai = 0; ai < 2; ++ai)
#pragma unroll
        for (int m = 0; m < 4; ++m)
#pragma unroll
          for (int bj = 0; bj < 2; ++bj)
            *(u32x4*)(O + (size_t)(row0 + ai * 128 + m * 16) * 3072 + u.pn * 256 + bj * 128 + wc * 32 + 8 * fq) = pack8(acc[ai][bj][m][0], acc[ai][bj][m][1]);
    } else if (wc == 0 && fq < 2) {
#pragma unroll
      for (int ai = 0; ai < 2; ++ai)
#pragma unroll
        for (int m = 0; m < 4; ++m) { float* o = BG + (size_t)(row0 + ai * 128 + m * 16) * 16 + 8 * fq; *(f32x4*)o = acc[ai][0][m][0]; *(f32x4*)(o + 4) = acc[ai][0][m][1]; }
    }
  }
};
struct EpiZG {
  static constexpr bool PERM = true, AFTER_DRAIN = false;
  bf16_t* O;
  DI void operator()(const f32x4 (&acc)[2][2][4][2], const Unit& u, int wr, int wc, int fr, int fq) const {
    const int row0 = u.pm * 256 + wr * 64 + fr; const bool sg = u.pn >= 4;
#pragma unroll
    for (int ai = 0; ai < 2; ++ai)
#pragma unroll
      for (int m = 0; m < 4; ++m)
#pragma unroll
        for (int bj = 0; bj < 2; ++bj) { f32x4 v0 = acc[ai][bj][m][0], v1 = acc[ai][bj][m][1];
          if (sg) {
#pragma unroll
            for (int e = 0; e < 4; ++e) { v0[e] = sigmoidf_(v0[e]); v1[e] = sigmoidf_(v1[e]); } }
          *(u32x4*)(O + (size_t)(row0 + ai * 128 + m * 16) * 3072 + u.pn * 256 + bj * 128 + wc * 32 + 8 * fq) = pack8(v0, v1); }
  }
};
struct EpiYa {
  static constexpr bool PERM = true, AFTER_DRAIN = false;
  bf16_t* PART; const bf16_t* ZG;
  DI void operator()(const f32x4 (&acc)[2][2][4][2], const Unit& u, int wr, int wc, int fr, int fq) const {
    const int row0 = u.pm * 256 + wr * 64 + fr;
#pragma unroll
    for (int ai = 0; ai < 2; ++ai)
#pragma unroll
      for (int m = 0; m < 4; ++m)
#pragma unroll
        for (int bj = 0; bj < 2; ++bj) { const int row = row0 + ai * 128 + m * 16, col = u.pn * 256 + bj * 128 + wc * 32 + 8 * fq;
          const u32x4 g = *(const u32x4*)(ZG + (size_t)row * 3072 + 1024 + col);
          f32x4 v0 = acc[ai][bj][m][0], v1 = acc[ai][bj][m][1];
          v0[0] *= bflo(g.x); v0[1] *= bfhi(g.x); v0[2] *= bflo(g.y); v0[3] *= bfhi(g.y); v1[0] *= bflo(g.z); v1[1] *= bfhi(g.z); v1[2] *= bflo(g.w); v1[3] *= bfhi(g.w);
          *(u32x4*)(PART + (size_t)row * 1024 + col) = pack8(v0, v1); }
  }
};
struct EpiYb {
  static constexpr bool PERM = true, AFTER_DRAIN = false;
  const bf16_t* PART; const bf16_t* ZG; bf16_t* MG;
  DI void operator()(const f32x4 (&acc)[2][2][4][2], const Unit& u, int wr, int wc, int fr, int fq) const {
    const int row0 = u.pm * 256 + wr * 64 + fr;
#pragma unroll
    for (int ai = 0; ai < 2; ++ai)
#pragma unroll
      for (int m = 0; m < 4; ++m)
#pragma unroll
        for (int bj = 0; bj < 2; ++bj) { const int row = row0 + ai * 128 + m * 16, col = u.pn * 256 + bj * 128 + wc * 32 + 8 * fq;
          const u32x4 g = *(const u32x4*)(ZG + (size_t)row * 3072 + 2048 + col);
          const u32x4 pq = *(const u32x4*)(PART + (size_t)row * 1024 + col); f32x4 v0 = {bflo(pq.x), bfhi(pq.x), bflo(pq.y), bfhi(pq.y)}, v1 = {bflo(pq.z), bfhi(pq.z), bflo(pq.w), bfhi(pq.w)};
          const f32x4 a0 = acc[ai][bj][m][0], a1 = acc[ai][bj][m][1];
          v0[0] += a0[0] * bflo(g.x); v0[1] += a0[1] * bfhi(g.x); v0[2] += a0[2] * bflo(g.y); v0[3] += a0[3] * bfhi(g.y);
          v1[0] += a1[0] * bflo(g.z); v1[1] += a1[1] * bfhi(g.z); v1[2] += a1[2] * bflo(g.w); v1[3] += a1[3] * bfhi(g.w);
          *(u32x4*)(MG + (size_t)row * 1024 + col) = pack8(v0, v1); }
  }
};
struct EpiRes {
  static constexpr bool PERM = true, AFTER_DRAIN = false;
  const float* RES; float* OUT;
  DI void operator()(const f32x4 (&acc)[2][2][4][2], const Unit& u, int wr, int wc, int fr, int fq) const {
    const int row0 = u.pm * 256 + wr * 64 + fr;
#pragma unroll
    for (int ai = 0; ai < 2; ++ai)
#pragma unroll
      for (int m = 0; m < 4; ++m)
#pragma unroll
        for (int bj = 0; bj < 2; ++bj) { const size_t off = (size_t)(row0 + ai * 128 + m * 16) * 1024 + u.pn * 256 + bj * 128 + wc * 32 + 8 * fq;
          const f32x4 r0 = *(const f32x4*)(RES + off), r1 = *(const f32x4*)(RES + off + 4);
          *(f32x4*)(OUT + off) = r0 + acc[ai][bj][m][0]; *(f32x4*)(OUT + off + 4) = r1 + acc[ai][bj][m][1]; }
  }
};
struct EpiResToB {
  static constexpr bool PERM = true, AFTER_DRAIN = false;
  const float* RES; bf16_t* OUT;
  DI void operator()(const f32x4 (&acc)[2][2][4][2], const Unit& u, int wr, int wc, int fr, int fq) const {
    const int row0 = u.pm * 256 + wr * 64 + fr;
#pragma unroll
    for (int ai = 0; ai < 2; ++ai)
#pragma unroll
      for (int m = 0; m < 4; ++m)
#pragma unroll
        for (int bj = 0; bj < 2; ++bj) { const size_t off = (size_t)(row0 + ai * 128 + m * 16) * 1024 + u.pn * 256 + bj * 128 + wc * 32 + 8 * fq;
          const f32x4 r0 = *(const f32x4*)(RES + off), r1 = *(const f32x4*)(RES + off + 4);
          *(u32x4*)(OUT + off) = pack8(r0 + acc[ai][bj][m][0], r1 + acc[ai][bj][m][1]); }
  }
};
struct EpiResFromB {
  static constexpr bool PERM = true, AFTER_DRAIN = false;
  const bf16_t* RES; float* OUT;
  DI void operator()(const f32x4 (&acc)[2][2][4][2], const Unit& u, int wr, int wc, int fr, int fq) const {
    const int row0 = u.pm * 256 + wr * 64 + fr;
#pragma unroll
    for (int ai = 0; ai < 2; ++ai)
#pragma unroll
      for (int m = 0; m < 4; ++m)
#pragma unroll
        for (int bj = 0; bj < 2; ++bj) { const size_t off = (size_t)(row0 + ai * 128 + m * 16) * 1024 + u.pn * 256 + bj * 128 + wc * 32 + 8 * fq;
          const u32x4 q = *(const u32x4*)(RES + off);
          const f32x4 r0 = {bflo(q.x), bfhi(q.x), bflo(q.y), bfhi(q.y)}, r1 = {bflo(q.z), bfhi(q.z), bflo(q.w), bfhi(q.w)};
          *(f32x4*)(OUT + off) = r0 + acc[ai][bj][m][0]; *(f32x4*)(OUT + off + 4) = r1 + acc[ai][bj][m][1]; }
  }
};
struct EpiResBB {
  static constexpr bool PERM = true, AFTER_DRAIN = false;
  const bf16_t* RES; bf16_t* OUT;
  DI void operator()(const f32x4 (&acc)[2][2][4][2], const Unit& u, int wr, int wc, int fr, int fq) const {
    const int row0 = u.pm * 256 + wr * 64 + fr;
#pragma unroll
    for (int ai = 0; ai < 2; ++ai)
#pragma unroll
      for (int m = 0; m < 4; ++m)
#pragma unroll
        for (int bj = 0; bj < 2; ++bj) { const size_t off = (size_t)(row0 + ai * 128 + m * 16) * 1024 + u.pn * 256 + bj * 128 + wc * 32 + 8 * fq;
          const u32x4 q = *(const u32x4*)(RES + off);
          const f32x4 r0 = {bflo(q.x), bfhi(q.x), bflo(q.y), bfhi(q.y)}, r1 = {bflo(q.z), bfhi(q.z), bflo(q.w), bfhi(q.w)};
          *(u32x4*)(OUT + off) = pack8(r0 + acc[ai][bj][m][0], r1 + acc[ai][bj][m][1]); }
  }
};
struct EpiSwiglu {
  static constexpr bool PERM = true, AFTER_DRAIN = false;
  bf16_t* ACT;
  DI void operator()(const f32x4 (&acc)[2][2][4][2], const Unit& u, int wr, int wc, int fr, int fq) const {
    const int row0 = u.pm * 256 + wr * 64 + fr;
#pragma unroll
    for (int ai = 0; ai < 2; ++ai)
#pragma unroll
      for (int m = 0; m < 4; ++m) { f32x4 v0, v1;
#pragma unroll
        for (int e = 0; e < 4; ++e) { v0[e] = siluf_(acc[ai][0][m][0][e]) * acc[ai][1][m][0][e]; v1[e] = siluf_(acc[ai][0][m][1][e]) * acc[ai][1][m][1][e]; }
        *(u32x4*)(ACT + (size_t)(row0 + ai * 128 + m * 16) * FF_ + u.pn * 128 + wc * 32 + 8 * fq) = pack8(v0, v1); }
  }
};
DI void tr_item(const float* W, int ldw, int K, bf16_t* WT, LAS float* scr, int k0, int lane) {
  float tv[32];
#pragma unroll
  for (int i = 0; i < 32; ++i) tv[i] = W[(size_t)(k0 + 2 * i + (lane >> 5)) * ldw + (lane & 31)];
#pragma unroll
  for (int i = 0; i < 32; ++i) scr[(2 * i + (lane >> 5)) * 33 + (lane & 31)] = tv[i];
  asm volatile("s_waitcnt lgkmcnt(0)" ::: "memory");
  const int c = lane & 7;
#pragma unroll
  for (int j = 0; j < 4; ++j) { const int n = (lane >> 3) + 8 * j; const LAS float* s = scr + (8 * c) * 33 + n;
    u32x4 o; o.x = pk2(s[0 * 33], s[1 * 33]); o.y = pk2(s[2 * 33], s[3 * 33]); o.z = pk2(s[4 * 33], s[5 * 33]); o.w = pk2(s[6 * 33], s[7 * 33]);
    *(u32x4*)(WT + (size_t)n * K + k0 + 8 * c) = o; }
  asm volatile("s_waitcnt lgkmcnt(0)" ::: "memory");
}
DI void rms_row_bf16(const float* xrow, const float* w, bf16_t* orow, int lane) {
  const f32x4* xr = (const f32x4*)xrow + lane; const f32x4* wr = (const f32x4*)w + lane;
  f32x4 v[4]; float s = 0.f;
#pragma unroll
  for (int j = 0; j < 4; ++j) { v[j] = xr[64 * j]; s += (v[j].x * v[j].x + v[j].y * v[j].y) + (v[j].z * v[j].z + v[j].w * v[j].w); }
  const float r = 1.f / sqrtf(wave_sum(s, lane) * (1.f / 1024.f) + 1e-6f);
  unsigned long long* o8 = (unsigned long long*)orow + lane;
#pragma unroll
  for (int j = 0; j < 4; ++j) { const f32x4 g = wr[64 * j];
    o8[64 * j] = (unsigned long long)pk2(v[j].x * r * g.x, v[j].y * r * g.y) | ((unsigned long long)pk2(v[j].z * r * g.z, v[j].w * r * g.w) << 32); }
}
DI void rms_row2_bf16(const float* x0, const float* x1, const float* w, bf16_t* o0, bf16_t* o1, int lane) {
  const f32x4* xa = (const f32x4*)x0 + lane; const f32x4* xb = (const f32x4*)x1 + lane; const f32x4* wr = (const f32x4*)w + lane;
  f32x4 va[4], vb[4]; float sa = 0.f, sb = 0.f;
#pragma unroll
  for (int j = 0; j < 4; ++j) { va[j] = xa[64 * j]; vb[j] = xb[64 * j]; }
#pragma unroll
  for (int j = 0; j < 4; ++j) { sa += (va[j].x * va[j].x + va[j].y * va[j].y) + (va[j].z * va[j].z + va[j].w * va[j].w); sb += (vb[j].x * vb[j].x + vb[j].y * vb[j].y) + (vb[j].z * vb[j].z + vb[j].w * vb[j].w); }
  const float ra = 1.f / sqrtf(wave_sum(sa, lane) * (1.f / 1024.f) + 1e-6f), rb = 1.f / sqrtf(wave_sum(sb, lane) * (1.f / 1024.f) + 1e-6f);
  unsigned long long* pa = (unsigned long long*)o0 + lane; unsigned long long* pb = (unsigned long long*)o1 + lane;
#pragma unroll
  for (int j = 0; j < 4; ++j) { const f32x4 g = wr[64 * j];
    pa[64 * j] = (unsigned long long)pk2(va[j].x * ra * g.x, va[j].y * ra * g.y) | ((unsigned long long)pk2(va[j].z * ra * g.z, va[j].w * ra * g.w) << 32);
    pb[64 * j] = (unsigned long long)pk2(vb[j].x * rb * g.x, vb[j].y * rb * g.y) | ((unsigned long long)pk2(vb[j].z * rb * g.z, vb[j].w * rb * g.w) << 32); }
}
DI void p0_prologue(const Params& p, lds_t lds, int wv) { TIDS();
  unsigned char* ws = p.ws;
  LAS float* scr = (LAS float*)(lds + wave * 16384);
  const int gw = blockIdx.x * 8 + wave, NGW = gridDim.x * 8;
  bf16_t* WIN = (bf16_t*)(ws + WS_WIN);
  constexpr int I0 = 16 * 144, I1 = 16 * 96, I2 = 16, I3 = 16 * 32, I4 = 16 * 64, I5 = 16 * 32, I6 = 8 * 32, I7 = 16 * 32, I8 = 16 * 176, I9 = 44 * 32;
  constexpr int NITEMS = I0 + I1 + I2 + I3 + I4 + I5 + I6 + I7 + I8 + I9;
  for (int it = gw; it < NITEMS; it += NGW) {
    int r = it;
    if (r < I0) { const int kb = r / 144, nb = r % 144; tr_item(p.w_in + 4112 + 32 * nb, IN_, 1024, WIN + (size_t)(0 + 32 * nb) * 1024, scr, 64 * kb, lane); continue; } r -= I0;
    if (r < I1) { const int kb = r / 96, nb = r % 96; tr_item(p.w_in + 0 + 32 * nb, IN_, 1024, WIN + (size_t)(4608 + 32 * nb) * 1024, scr, 64 * kb, lane); continue; } r -= I1;
    if (r < I2) { const int kb = r; tr_item(p.w_in + 4096, IN_, 1024, WIN + (size_t)7680 * 1024, scr, 64 * kb, lane); continue; } r -= I2;
    if (r < I3) { const int kb = r / 32, nb = r % 32; tr_item(p.w_in + 3072 + 32 * nb, IN_, 1024, WIN + (size_t)(7936 + 32 * nb) * 1024, scr, 64 * kb, lane); continue; } r -= I3;
    if (r < I4) { const int kb = r / 64, nb = r % 64; tr_item(p.w_in + 8720 + 32 * nb, IN_, 1024, WIN + (size_t)(8960 + 32 * nb) * 1024, scr, 64 * kb, lane); continue; } r -= I4;
    if (r < I5) { const int kb = r / 32, nb = r % 32; tr_item(p.w_proj_a + 32 * nb, 1024, 1024, (bf16_t*)(ws + WS_WPA) + (size_t)(32 * nb) * 1024, scr, 64 * kb, lane); continue; } r -= I5;
    if (r < I6) { const int kb = r / 32, nb = r % 32; tr_item(p.w_proj_b + 32 * nb, 1024, 512, (bf16_t*)(ws + WS_WPB) + (size_t)(32 * nb) * 512, scr, 64 * kb, lane); continue; } r -= I6;
    if (r < I7) { const int kb = r / 32, nb = r % 32; tr_item(p.w_out + 32 * nb, 1024, 1024, (bf16_t*)(ws + WS_WOUT) + (size_t)(32 * nb) * 1024, scr, 64 * kb, lane); continue; } r -= I7;
    if (r < I8) { const int kb = r / 176, nb = r % 176; const int pn = nb >> 3, bj = (nb >> 2) & 1, r0 = (nb & 3) * 32;
      tr_item(p.w_gate_up + bj * FF_ + 128 * pn + r0, 2 * FF_, 1024, (bf16_t*)(ws + WS_WGU) + (size_t)(32 * nb) * 1024, scr, 64 * kb, lane); continue; } r -= I8;
    { const int kb = r / 32, nb = r % 32; tr_item(p.w_down + 32 * nb, 1024, FF_, (bf16_t*)(ws + WS_WDN) + (size_t)(32 * nb) * FF_, scr, 64 * kb, lane); }
  }
  { float* rope = (float*)(ws + WS_ROPE);
    for (int i = blockIdx.x * 512 + tid; i < L_ * 16; i += gridDim.x * 512) { const int pos = i >> 4, f = i & 15;
      const float invf = powf(500000.0f, -(float)f * (1.0f / 16.0f)); const float ang = (float)pos * invf; float sn, cs; sincosf(ang, &sn, &cs);
      rope[2 * i] = cs; rope[2 * i + 1] = sn; } }
  bf16_t* H1 = (bf16_t*)((unsigned char*)p.out + DO_H1);
  for (int m = gw; m < T_; m += 2 * NGW) { const int m2 = (m + NGW < T_) ? m + NGW : m; rms_row2_bf16(p.x + (size_t)m * D_, p.x + (size_t)m2 * D_, p.norm1_w, H1 + (size_t)m * D_, H1 + (size_t)m2 * D_, lane); }
}

constexpr int AT_RS = 272;
constexpr int AT_KV_BYTES = 272 * AT_RS;
constexpr int AT_PS = 336;
constexpr int AT_P_OFF = AT_KV_BYTES, AT_P_WAVE = 16 * AT_PS;
DI void attn_unit_coords(int unit, int& g, int& dsh, int& hs, int& b, int& r, int& nb, int& head) {
  g = unit >> 10; const int rem = unit & 1023; dsh = 2 * g; const int nbk = 32 >> dsh;
  hs = rem & 3; const int rest = rem >> 2; b = rest >> 5; const int within = rest & 31; r = within / nbk; nb = within % nbk; head = g * 4 + hs;
}
DI void attn_load(u32x4 (&v)[8], const bf16_t* base  , int b, int r, int nb, int dsh, int tid) {
#pragma unroll
  for (int pss = 0; pss < 8; ++pss) { const int idx = tid + 512 * pss, key = idx >> 4, ch = idx & 15;
    const int mi = (nb - 1) * 128 + key; v[pss] = (u32x4){0u, 0u, 0u, 0u};
    if (mi >= 0) { const size_t row = (size_t)b * L_ + ((size_t)mi << dsh) + r; v[pss] = *(const u32x4*)(base + row * 4608 + ch * 8); } }
}
DI void attn_store(lds_t buf, const u32x4 (&v)[8], int tid) {
#pragma unroll
  for (int pss = 0; pss < 8; ++pss) { const int idx = tid + 512 * pss, key = idx >> 4, ch = idx & 15; *(LAS u32x4*)(buf + key * AT_RS + ch * 16) = v[pss]; }
  if (tid < 256) { const int key = 256 + (tid >> 4), ch = tid & 15; *(LAS u32x4*)(buf + key * AT_RS + ch * 16) = (u32x4){0u, 0u, 0u, 0u}; }
}
#define LDS_BAR() do { asm volatile("s_waitcnt lgkmcnt(0)" ::: "memory"); __builtin_amdgcn_s_barrier(); asm volatile("" ::: "memory"); } while (0)
DI void attn_phase(const Params& p, lds_t lds, int wv) { TIDS();
  const bf16_t* AQKV = (const bf16_t*)(p.ws + WS_AQKV); bf16_t* OG = (bf16_t*)(p.ws + WS_OG); float* LSE = (float*)(p.ws + WS_LSE);
  const int fr = lane & 15, fq = lane >> 4;
  lds_t Pw = lds + AT_P_OFF + wave * AT_P_WAVE;
  u32x4 kreg[8], vreg[8]; bf16x8 qf[4];
  int g, dsh, hs, b, r, nb, head;
  if ((int)blockIdx.x < 3072) {
    attn_unit_coords(blockIdx.x, g, dsh, hs, b, r, nb, head);
    attn_load(kreg, AQKV + 1536 + head * 128, b, r, nb, dsh, tid);
    const size_t qrow = (size_t)b * L_ + (((size_t)(nb * 128 + 16 * wave + fr)) << dsh) + r; const bf16_t* qp = AQKV + qrow * 4608 + head * 128 + fq * 8;
#pragma unroll
    for (int ks = 0; ks < 4; ++ks) qf[ks] = *(const bf16x8*)(qp + ks * 32);
  }
  for (int unit = blockIdx.x; unit < 3072; unit += gridDim.x) {
    attn_unit_coords(unit, g, dsh, hs, b, r, nb, head);
    LDS_BAR();
    attn_store(lds, kreg, tid);
    attn_load(vreg, AQKV + 3072 + head * 128, b, r, nb, dsh, tid);
    bf16x8 qc[4];
#pragma unroll
    for (int ks = 0; ks < 4; ++ks) qc[ks] = qf[ks];
    LDS_BAR();
    f32x4 sc[9];
#pragma unroll
    for (int ct = 0; ct < 9; ++ct) { sc[ct] = (f32x4){0.f, 0.f, 0.f, 0.f};
      lds_t kp = lds + (16 * (wave + ct) + fr) * AT_RS + fq * 16;
#pragma unroll
      for (int ks = 0; ks < 4; ++ks) sc[ct] = MFMA16(qc[ks], lds_ld16(kp + ks * 64), sc[ct]); }
    const float SCL = 0.08838834764831845f * 1.4426950408889634f;
    float mx[4] = {-3.0e38f, -3.0e38f, -3.0e38f, -3.0e38f};
#pragma unroll
    for (int ct = 0; ct < 9; ++ct) { const bool tile_ok = (nb > 0) || (wave + ct >= 8);
#pragma unroll
      for (int j = 0; j < 4; ++j) { bool ok = tile_ok;
        if (ct == 0) ok = ok && (fr >= 4 * fq + j);
        if (ct == 8) ok = ok && (fr <= 4 * fq + j);
        const float s = ok ? sc[ct][j] : -3.0e38f; sc[ct][j] = s; mx[j] = fmaxf(mx[j], s); } }
#pragma unroll
    for (int j = 0; j < 4; ++j) mx[j] = max16(mx[j], lane) * SCL;
    float den[4] = {0.f, 0.f, 0.f, 0.f};
#pragma unroll
    for (int ct = 0; ct < 9; ++ct)
#pragma unroll
      for (int j = 0; j < 4; ++j) { const float e = __builtin_amdgcn_exp2f(fmaf(sc[ct][j], SCL, -mx[j])); den[j] += e;
        *(LAS bf16_t*)(Pw + (4 * fq + j) * AT_PS + (16 * ct + fr) * 2) = (bf16_t)f2bf(e); }
#pragma unroll
    for (int j = 0; j < 4; ++j) { *(LAS bf16_t*)(Pw + (4 * fq + j) * AT_PS + (144 + fr) * 2) = 0; den[j] = sum16(den[j], lane); }
    LDS_BAR();
    attn_store(lds, vreg, tid);
    { const int nu = unit + gridDim.x;
      if (nu < 3072) { int g2, dsh2, hs2, b2, r2, nb2, head2; attn_unit_coords(nu, g2, dsh2, hs2, b2, r2, nb2, head2);
        attn_load(kreg, AQKV + 1536 + head2 * 128, b2, r2, nb2, dsh2, tid);
        const size_t qrow = (size_t)b2 * L_ + (((size_t)(nb2 * 128 + 16 * wave + fr)) << dsh2) + r2; const bf16_t* qp = AQKV + qrow * 4608 + head2 * 128 + fq * 8;
#pragma unroll
        for (int ks = 0; ks < 4; ++ks) qf[ks] = *(const bf16x8*)(qp + ks * 32); } }
    LDS_BAR();
    f32x4 oa[8];
#pragma unroll
    for (int dt = 0; dt < 8; ++dt) oa[dt] = (f32x4){0.f, 0.f, 0.f, 0.f};
#pragma unroll
    for (int ks = 0; ks < 5; ++ks) { const bf16x8 a = lds_ld16(Pw + fr * AT_PS + (ks * 32 + fq * 8) * 2);
      lds_t vp = lds + (16 * wave + ks * 32 + fq * 8 + (fr >> 2)) * AT_RS + (fr & 3) * 8;
#pragma unroll
      for (int dt = 0; dt < 8; ++dt) { const s16x4 lo = lds_tr(vp + dt * 32), hi = lds_tr(vp + 4 * AT_RS + dt * 32);
        const bf16x8 bb = __builtin_shufflevector(lo, hi, 0, 1, 2, 3, 4, 5, 6, 7); oa[dt] = MFMA16(a, bb, oa[dt]); } }
#pragma unroll
    for (int j = 0; j < 4; ++j) { const int qi = 16 * wave + 4 * fq + j; const size_t row = (size_t)b * L_ + (((size_t)(nb * 128 + qi)) << dsh) + r;
      const float inv = 1.f / den[j]; bf16_t* op = OG + ((size_t)g * T_ + row) * 512 + hs * 128 + fr;
#pragma unroll
      for (int dt = 0; dt < 8; ++dt) op[dt * 16] = (bf16_t)f2bf(oa[dt][j] * inv);
      if (fr == 0) LSE[((size_t)g * T_ + row) * 4 + hs] = (mx[j] + log2f(den[j])) * 0.6931471805599453f; }
  }
}
DI void combine_phase(const Params& p, int wv) { TIDS();
  const bf16_t* OG = (const bf16_t*)(p.ws + WS_OG); const float* LSE = (const float*)(p.ws + WS_LSE); bf16_t* OB = (bf16_t*)((unsigned char*)p.out + DO_OB);
  for (size_t it = (size_t)blockIdx.x * 512 + tid; it < (size_t)T_ * 64; it += (size_t)gridDim.x * 512) {
    const size_t row = it >> 6; const int c = (int)(it & 63), hs = c >> 4;
    const float l0 = LSE[row * 4 + hs], l1 = LSE[((size_t)T_ + row) * 4 + hs], l2 = LSE[((size_t)2 * T_ + row) * 4 + hs];
    const float mx = fmaxf(l0, fmaxf(l1, l2)); float e0 = __expf(l0 - mx), e1 = __expf(l1 - mx), e2 = __expf(l2 - mx); const float inv = 1.f / (e0 + e1 + e2); e0 *= inv; e1 *= inv; e2 *= inv;
    const u32x4 a = *(const u32x4*)(OG + row * 512 + c * 8), bq = *(const u32x4*)(OG + ((size_t)T_ + row) * 512 + c * 8), cq = *(const u32x4*)(OG + ((size_t)2 * T_ + row) * 512 + c * 8);
    u32x4 o;
    o.x = pk2(e0 * bflo(a.x) + e1 * bflo(bq.x) + e2 * bflo(cq.x), e0 * bfhi(a.x) + e1 * bfhi(bq.x) + e2 * bfhi(cq.x));
    o.y = pk2(e0 * bflo(a.y) + e1 * bflo(bq.y) + e2 * bflo(cq.y), e0 * bfhi(a.y) + e1 * bfhi(bq.y) + e2 * bfhi(cq.y));
    o.z = pk2(e0 * bflo(a.z) + e1 * bflo(bq.z) + e2 * bflo(cq.z), e0 * bfhi(a.z) + e1 * bfhi(bq.z) + e2 * bfhi(cq.z));
    o.w = pk2(e0 * bflo(a.w) + e1 * bflo(bq.w) + e2 * bflo(cq.w), e0 * bfhi(a.w) + e1 * bfhi(bq.w) + e2 * bfhi(cq.w));
    *(u32x4*)(OB + row * 512 + c * 8) = o;
  }
}

DI void bg_phase(const Params& p, int wv) { TIDS();
  const bf16_t* H1 = (const bf16_t*)((const unsigned char*)p.out + DO_H1); const bf16_t* WB = (const bf16_t*)(p.ws + WS_WIN) + (size_t)7680 * 1024; float* BG = (float*)(p.ws + WS_BG);
  const int fr = lane & 15, fq = lane >> 4;
  for (int tile = blockIdx.x * 8 + wave; tile < T_ / 16; tile += gridDim.x * 8) {
    const bf16_t* ap = H1 + ((size_t)tile * 16 + fr) * 1024 + fq * 8; const bf16_t* bp = WB + (size_t)fr * 1024 + fq * 8;
    f32x4 acc0 = {0.f, 0.f, 0.f, 0.f}, acc1 = {0.f, 0.f, 0.f, 0.f};
#pragma unroll 8
    for (int ks = 0; ks < 32; ks += 2) { acc0 = MFMA16(*(const bf16x8*)(ap + ks * 32), *(const bf16x8*)(bp + ks * 32), acc0); acc1 = MFMA16(*(const bf16x8*)(ap + ks * 32 + 32), *(const bf16x8*)(bp + ks * 32 + 32), acc1); }
#pragma unroll
    for (int j = 0; j < 4; ++j) BG[((size_t)tile * 16 + 4 * fq + j) * 16 + fr] = acc0[j] + acc1[j];
  }
}
template <int NL> DI void lds_row_read(f32x4 (&a)[16], unsigned addr);
template <> DI void lds_row_read<16>(f32x4 (&a)[16], unsigned addr) {
  asm volatile("ds_read_b128 %0, %16\n\tds_read_b128 %1, %16 offset:16\n\tds_read_b128 %2, %16 offset:32\n\tds_read_b128 %3, %16 offset:48\n\t"
               "ds_read_b128 %4, %16 offset:64\n\tds_read_b128 %5, %16 offset:80\n\tds_read_b128 %6, %16 offset:96\n\tds_read_b128 %7, %16 offset:112\n\t"
               "ds_read_b128 %8, %16 offset:128\n\tds_read_b128 %9, %16 offset:144\n\tds_read_b128 %10, %16 offset:160\n\tds_read_b128 %11, %16 offset:176\n\t"
               "ds_read_b128 %12, %16 offset:192\n\tds_read_b128 %13, %16 offset:208\n\tds_read_b128 %14, %16 offset:224\n\tds_read_b128 %15, %16 offset:240\n\ts_waitcnt lgkmcnt(0)"
               : "=&v"(a[0]), "=&v"(a[1]), "=&v"(a[2]), "=&v"(a[3]), "=&v"(a[4]), "=&v"(a[5]), "=&v"(a[6]), "=&v"(a[7]), "=&v"(a[8]), "=&v"(a[9]), "=&v"(a[10]), "=&v"(a[11]), "=&v"(a[12]), "=&v"(a[13]), "=&v"(a[14]), "=&v"(a[15])
               : "v"(addr) : "memory");
}
template <> DI void lds_row_read<12>(f32x4 (&a)[16], unsigned addr) {
  asm volatile("ds_read_b128 %0, %12\n\tds_read_b128 %1, %12 offset:16\n\tds_read_b128 %2, %12 offset:32\n\tds_read_b128 %3, %12 offset:48\n\t"
               "ds_read_b128 %4, %12 offset:64\n\tds_read_b128 %5, %12 offset:80\n\tds_read_b128 %6, %12 offset:96\n\tds_read_b128 %7, %12 offset:112\n\t"
               "ds_read_b128 %8, %12 offset:128\n\tds_read_b128 %9, %12 offset:144\n\tds_read_b128 %10, %12 offset:160\n\tds_read_b128 %11, %12 offset:176\n\ts_waitcnt lgkmcnt(0)"
               : "=&v"(a[0]), "=&v"(a[1]), "=&v"(a[2]), "=&v"(a[3]), "=&v"(a[4]), "=&v"(a[5]), "=&v"(a[6]), "=&v"(a[7]), "=&v"(a[8]), "=&v"(a[9]), "=&v"(a[10]), "=&v"(a[11])
               : "v"(addr) : "memory");
}
template <> DI void lds_row_read<8>(f32x4 (&a)[16], unsigned addr) {
  asm volatile("ds_read_b128 %0, %8\n\tds_read_b128 %1, %8 offset:16\n\tds_read_b128 %2, %8 offset:32\n\tds_read_b128 %3, %8 offset:48\n\t"
               "ds_read_b128 %4, %8 offset:64\n\tds_read_b128 %5, %8 offset:80\n\tds_read_b128 %6, %8 offset:96\n\tds_read_b128 %7, %8 offset:112\n\ts_waitcnt lgkmcnt(0)"
               : "=&v"(a[0]), "=&v"(a[1]), "=&v"(a[2]), "=&v"(a[3]), "=&v"(a[4]), "=&v"(a[5]), "=&v"(a[6]), "=&v"(a[7])
               : "v"(addr) : "memory");
}
template <> DI void lds_row_read<4>(f32x4 (&a)[16], unsigned addr) {
  asm volatile("ds_read_b128 %0, %4\n\tds_read_b128 %1, %4 offset:16\n\tds_read_b128 %2, %4 offset:32\n\tds_read_b128 %3, %4 offset:48\n\ts_waitcnt lgkmcnt(0)"
               : "=&v"(a[0]), "=&v"(a[1]), "=&v"(a[2]), "=&v"(a[3]) : "v"(addr) : "memory");
}
template <int J> DI void subst_rows(float (&t)[64], unsigned abase) {
  if constexpr (J < 63) {
    constexpr int I40 = (J + 1) / 4, G0 = I40 / 4;
    const float xj = t[J];
    if constexpr (G0 < 2) {
      f32x4 a[16]; lds_row_read<8 - 4 * G0>(a, abase + (unsigned)((J * 68 + 16 * G0) * 4));
#pragma unroll
      for (int i4 = (I40 > 4 * G0 ? I40 : 4 * G0); i4 < 8; ++i4) { const f32x4 v = a[i4 - 4 * G0];
        t[4 * i4] -= v[0] * xj; t[4 * i4 + 1] -= v[1] * xj; t[4 * i4 + 2] -= v[2] * xj; t[4 * i4 + 3] -= v[3] * xj; }
    }
    { constexpr int G1 = G0 < 2 ? 2 : G0;
      f32x4 a[16]; lds_row_read<16 - 4 * G1>(a, abase + (unsigned)((J * 68 + 16 * G1) * 4));
#pragma unroll
      for (int i4 = (I40 > 4 * G1 ? I40 : 4 * G1); i4 < 16; ++i4) { const f32x4 v = a[i4 - 4 * G1];
        t[4 * i4] -= v[0] * xj; t[4 * i4 + 1] -= v[1] * xj; t[4 * i4 + 2] -= v[2] * xj; t[4 * i4 + 3] -= v[3] * xj; }
    }
    subst_rows<J + 1>(t, abase);
  }
}
constexpr int CP_RS = 272;
constexpr int CP_K = 0, CP_Q = 17408, CP_VB = 34816, CP_KG = 52224, CP_AF = 69632  , CP_TB = 87040  , CP_GC = 96256, CP_BETA = 96512;
DI void chunkprep_phase(const Params& p, lds_t lds, int wv) { TIDS(); float* QS1 = (float*)(p.ws + 52 * MiB);
  unsigned char* ws = p.ws;
  const bf16_t* DQKV = (const bf16_t*)(ws + WS_DQKV); const float* BG = (const float*)(ws + WS_BG);
  bf16_t* QD = (bf16_t*)(ws + WS_QD); bf16_t* KDT = (bf16_t*)(ws + WS_KDT); bf16_t* Ug = (bf16_t*)(ws + WS_U); bf16_t* Wg = (bf16_t*)(ws + WS_W);
  bf16_t* QK = (bf16_t*)((unsigned char*)p.out + DO_QK); float* GL = (float*)(ws + WS_GL);
  LAS float* gcs = (LAS float*)(lds + CP_GC); LAS float* betas = (LAS float*)(lds + CP_BETA); LAS float* Af = (LAS float*)(lds + CP_AF);
  const int fr = lane & 15, fq = lane >> 4;
  for (int unit = blockIdx.x; unit < 4096; unit += gridDim.x) {
    const int bh = unit >> 6, n = unit & 63, b = bh >> 3, h = bh & 7;
    const size_t row0 = (size_t)b * L_ + n * 64;
    __syncthreads();
    if (wave == 0) {
      const float db = BG[(row0 + lane) * 16 + h], da = BG[(row0 + lane) * 16 + 8 + h];
      const float xx = da + p.dt_bias[h]; const float sp = (xx > 20.f) ? xx : log1pf(__expf(xx));
      float gg = -__expf(p.a_log[h]) * sp;
#pragma unroll
      for (int o = 1; o < 64; o <<= 1) { const float t = BPERM((lane - o) & 63, gg); if (lane >= o) gg += t; }
      gcs[lane] = gg; betas[lane] = sigmoidf_(db);
      if (lane == 63) GL[unit] = __expf(gg);
      QS1[(size_t)bh * L_ + n * 64 + lane] = 1.f;
    }
    float val[6][8];
#pragma unroll
    for (int i = 0; i < 6; ++i) { const int it = (tid >> 4) + 32 * i, s = it >> 6, c = it & 63, tpos = n * 64 + c; const int col = s * 1024 + h * 128 + fr * 8;
      float y[8];
#pragma unroll
      for (int e = 0; e < 8; ++e) y[e] = 0.f;
#pragma unroll
      for (int j = 0; j < 4; ++j) { if (tpos - 3 + j >= 0) {
          const u32x4 xv = *(const u32x4*)(DQKV + (row0 + c - 3 + j) * 3072 + col); const f32x4 w0 = *(const f32x4*)(p.conv_w + (size_t)j * 3072 + col), w1 = *(const f32x4*)(p.conv_w + (size_t)j * 3072 + col + 4);
          y[0] += w0[0] * bflo(xv.x); y[1] += w0[1] * bfhi(xv.x); y[2] += w0[2] * bflo(xv.y); y[3] += w0[3] * bfhi(xv.y);
          y[4] += w1[0] * bflo(xv.z); y[5] += w1[1] * bfhi(xv.z); y[6] += w1[2] * bflo(xv.w); y[7] += w1[3] * bfhi(xv.w); } }
      float ss = 0.f;
#pragma unroll
      for (int e = 0; e < 8; ++e) { y[e] = siluf_(y[e]); ss += y[e] * y[e]; }
      ss = sum16(ss, lane);
      float scl = 1.f; if (s < 2) scl = 1.f / sqrtf(ss + 1e-6f); if (s == 0) scl *= 0.08838834764831845f;
#pragma unroll
      for (int e = 0; e < 8; ++e) val[i][e] = y[e] * scl; }
    __syncthreads();
    const float gclast = gcs[63];
#pragma unroll
    for (int i = 0; i < 6; ++i) { const int it = (tid >> 4) + 32 * i, s = it >> 6, c = it & 63; const float gc = gcs[c], be = betas[c];
      if (s == 0) { const float eg = __expf(gc);
        u32x4 a, d; a.x = pk2(val[i][0], val[i][1]); a.y = pk2(val[i][2], val[i][3]); a.z = pk2(val[i][4], val[i][5]); a.w = pk2(val[i][6], val[i][7]);
        d.x = pk2(val[i][0] * eg, val[i][1] * eg); d.y = pk2(val[i][2] * eg, val[i][3] * eg); d.z = pk2(val[i][4] * eg, val[i][5] * eg); d.w = pk2(val[i][6] * eg, val[i][7] * eg);
        *(LAS u32x4*)(lds + CP_Q + c * CP_RS + fr * 16) = a; *(u32x4*)(QD + ((size_t)bh * L_ + n * 64 + c) * 128 + fr * 8) = d;
      } else if (s == 1) { const float eb = be * __expf(gc), ed = __expf(gclast - gc);
        u32x4 a, d; a.x = pk2(val[i][0], val[i][1]); a.y = pk2(val[i][2], val[i][3]); a.z = pk2(val[i][4], val[i][5]); a.w = pk2(val[i][6], val[i][7]);
        d.x = pk2(val[i][0] * eb, val[i][1] * eb); d.y = pk2(val[i][2] * eb, val[i][3] * eb); d.z = pk2(val[i][4] * eb, val[i][5] * eb); d.w = pk2(val[i][6] * eb, val[i][7] * eb);
        *(LAS u32x4*)(lds + CP_K + c * CP_RS + fr * 16) = a; *(LAS u32x4*)(lds + CP_KG + c * CP_RS + fr * 16) = d;
        bf16_t* kt = KDT + ((size_t)unit * 128 + fr * 8) * 64 + c;
#pragma unroll
        for (int e = 0; e < 8; ++e) kt[e * 64] = (bf16_t)f2bf(val[i][e] * ed);
      } else { u32x4 d; d.x = pk2(val[i][0] * be, val[i][1] * be); d.y = pk2(val[i][2] * be, val[i][3] * be); d.z = pk2(val[i][4] * be, val[i][5] * be); d.w = pk2(val[i][6] * be, val[i][7] * be);
        *(LAS u32x4*)(lds + CP_VB + c * CP_RS + fr * 16) = d; } }
    __syncthreads();
    {
      const int rt = wave & 3; lds_t ap = lds + (wave < 4 ? CP_K : CP_Q) + (16 * rt + fr) * CP_RS + fq * 16;
      bf16x8 af[4];
#pragma unroll
      for (int ks = 0; ks < 4; ++ks) af[ks] = lds_ld16(ap + ks * 64);
#pragma unroll
      for (int ct = 0; ct < 4; ++ct) { f32x4 acc = {0.f, 0.f, 0.f, 0.f}; lds_t bp = lds + CP_K + (16 * ct + fr) * CP_RS + fq * 16;
#pragma unroll
        for (int ks = 0; ks < 4; ++ks) acc = MFMA16(af[ks], lds_ld16(bp + ks * 64), acc);
        const int s = 16 * ct + fr; const float gs = gcs[s];
#pragma unroll
        for (int j = 0; j < 4; ++j) { const int c = 16 * rt + 4 * fq + j; const float dec = __expf(gcs[c] - gs);
          if (wave < 4) Af[s * 68 + c] = (c > s) ? betas[c] * acc[j] * dec : 0.f;
          else QK[((size_t)unit * 64 + c) * 64 + s] = (bf16_t)f2bf((c >= s) ? acc[j] * dec : 0.f); } }
    }
    __syncthreads();
    if (wave == 0) {
      float t[64];
      unsigned abase = (unsigned)(size_t)Af; asm volatile("" : "+v"(abase));
#pragma unroll
      for (int i = 0; i < 64; ++i) t[i] = (lane == i) ? 1.f : 0.f;
      subst_rows<0>(t, abase);
#pragma unroll
      for (int i = 0; i < 64; ++i) *(LAS bf16_t*)(lds + CP_TB + i * 144 + lane * 2) = (bf16_t)f2bf(t[i]);
    }
    __syncthreads();
    {
      const int rt = wave & 3; lds_t tp = lds + CP_TB + (16 * rt + fr) * 144 + fq * 16;
      const bf16x8 a0 = lds_ld16(tp), a1 = lds_ld16(tp + 64);
      lds_t xb = lds + (wave < 4 ? CP_VB : CP_KG) + (fq * 8 + (fr >> 2)) * CP_RS + (fr & 3) * 8;
      bf16_t* og = (wave < 4 ? Ug : Wg) + ((size_t)bh * L_ + n * 64 + 16 * rt + 4 * fq) * 128 + fr;
#pragma unroll
      for (int ct = 0; ct < 8; ++ct) { f32x4 acc = {0.f, 0.f, 0.f, 0.f};
        { const s16x4 lo = lds_tr(xb + ct * 32), hi = lds_tr(xb + 4 * CP_RS + ct * 32); acc = MFMA16(a0, __builtin_shufflevector(lo, hi, 0, 1, 2, 3, 4, 5, 6, 7), acc); }
        { const s16x4 lo = lds_tr(xb + 32 * CP_RS + ct * 32), hi = lds_tr(xb + 36 * CP_RS + ct * 32); acc = MFMA16(a1, __builtin_shufflevector(lo, hi, 0, 1, 2, 3, 4, 5, 6, 7), acc); }
#pragma unroll
        for (int j = 0; j < 4; ++j) og[(size_t)j * 128 + ct * 16] = (bf16_t)f2bf(acc[j]); }
    }
  }
}
constexpr int CW_TB = 0  , CW_CH = 9216  , CW_RAW = 14336  , CW_AT = 0  , CW_TAB = 18624  , CW_WAVE = 19648;
constexpr size_t WS_QS = 52 * MiB;
DI void conv8(const bf16_t* base, unsigned eoff, int tpos, const f32x4 (&w)[4][2], float (&y)[8]) {
#pragma unroll
  for (int e = 0; e < 8; ++e) y[e] = 0.f;
#pragma unroll
  for (int j = 0; j < 4; ++j) if (tpos - 3 + j >= 0) { const u32x4 xv = *(const u32x4*)(base + (eoff + (unsigned)(j * 3072) - 9216u));
      y[0] += w[j][0][0] * bflo(xv.x); y[1] += w[j][0][1] * bfhi(xv.x); y[2] += w[j][0][2] * bflo(xv.y); y[3] += w[j][0][3] * bfhi(xv.y);
      y[4] += w[j][1][0] * bflo(xv.z); y[5] += w[j][1][1] * bfhi(xv.z); y[6] += w[j][1][2] * bflo(xv.w); y[7] += w[j][1][3] * bfhi(xv.w); }
#pragma unroll
  for (int e = 0; e < 8; ++e) y[e] = siluf_(y[e]);
}
DI void load_convw(const float* cw, int col, f32x4 (&w)[4][2]) {
#pragma unroll
  for (int j = 0; j < 4; ++j) { w[j][0] = *(const f32x4*)(cw + (size_t)j * 3072 + col); w[j][1] = *(const f32x4*)(cw + (size_t)j * 3072 + col + 4); }
}
DI bf16x8 pack_y(const float (&y)[8], float s) { u32x4 v; v.x = pk2(y[0] * s, y[1] * s); v.y = pk2(y[2] * s, y[3] * s); v.z = pk2(y[4] * s, y[5] * s); v.w = pk2(y[6] * s, y[7] * s); return __builtin_bit_cast(bf16x8, v); }
#define TRI(r, c) ((r) * ((r) + 1) / 2 + (c))
template <int J> DI void subst_rl(float (&t)[64], const f32x4 (&A)[10]) {
  if constexpr (J < 63) {
    const float xj = t[J];
#pragma unroll
    for (int i = J + 1; i < 64; ++i) {
      const float a = __builtin_bit_cast(float, __builtin_amdgcn_readlane(__builtin_bit_cast(int, A[TRI(i >> 4, J >> 4)][i & 3]), 16 * ((i & 15) >> 2) + (J & 15)));
      t[i] -= a * xj; }
    if constexpr ((J & 3) == 3) __builtin_amdgcn_sched_barrier(0);
    subst_rl<J + 1>(t, A);
  }
}
DI void raw_issue(u32x4 (&raw)[5], const bf16_t* DQKV, unsigned rowbase  , int n64, int colbase, int ln) {
  asm volatile("" : "+v"(ln));
#pragma unroll
  for (int i = 0; i < 5; ++i) { const int item = ln + 64 * i, rr = item >> 2, pc = item & 3; raw[i] = (u32x4){0u, 0u, 0u, 0u};
    if (item < 268 && n64 - 3 + rr >= 0) raw[i] = *(const u32x4*)(DQKV + ((rowbase + (unsigned)rr) * 3072u + (unsigned)(colbase + pc * 8))); }
}
DI void raw_commit(lds_t rawl, const u32x4 (&raw)[5], int ln) {
  asm volatile("" : "+v"(ln));
#pragma unroll
  for (int i = 0; i < 5; ++i) { const int item = ln + 64 * i; if (item < 268) *(LAS u32x4*)(rawl + item * 16) = raw[i]; }
  asm volatile("" ::: "memory");
}
DI void conv8l(lds_t rawl, int c, int fq, const f32x4 (&w)[4][2], float (&y)[8]) {
#pragma unroll
  for (int e = 0; e < 8; ++e) y[e] = 0.f;
#pragma unroll
  for (int j = 0; j < 4; ++j) { const u32x4 xv = *(LAS u32x4*)(rawl + (c + j) * 64 + fq * 16);
    y[0] += w[j][0][0] * bflo(xv.x); y[1] += w[j][0][1] * bfhi(xv.x); y[2] += w[j][0][2] * bflo(xv.y); y[3] += w[j][0][3] * bfhi(xv.y);
    y[4] += w[j][1][0] * bflo(xv.z); y[5] += w[j][1][1] * bfhi(xv.z); y[6] += w[j][1][2] * bflo(xv.w); y[7] += w[j][1][3] * bfhi(xv.w); }
#pragma unroll
  for (int e = 0; e < 8; ++e) y[e] = siluf_(y[e]);
}
#ifndef NCM
#define NCM 63
#endif
DI void chunkprep_wave(const Params& p, lds_t lds, int wv) {
  const int wave = wv;
  unsigned char* ws = p.ws;
  const bf16_t* DQKV = (const bf16_t*)(ws + WS_DQKV); const float* BG = (const float*)(ws + WS_BG);
  bf16_t* Qg = (bf16_t*)(ws + WS_QD); bf16_t* KDT = (bf16_t*)(ws + WS_KDT); bf16_t* Ug = (bf16_t*)(ws + WS_U); bf16_t* Wg = (bf16_t*)(ws + WS_W);
  bf16_t* QK = (bf16_t*)((unsigned char*)p.out + DO_QK); float* GL = (float*)(ws + WS_GL); float* QS = (float*)(ws + WS_QS);
  lds_t wl = lds + wave * CW_WAVE; LAS float* tab = (LAS float*)(wl + CW_TAB);
  for (int unit = blockIdx.x * 8 + wave; unit < 4096; unit += gridDim.x * 8) {
    const int ln = lane_id();
    const int fr = ln & 15, fq = ln >> 4;
    const int bh = unit >> 6, n = unit & 63, b = bh >> 3, h = bh & 7;
    const size_t row0 = (size_t)b * L_ + n * 64, trow0 = (size_t)bh * L_ + n * 64;
    float gclast;
    { const float db = BG[((unsigned)row0 + ln) * 16u + h], da = BG[((unsigned)row0 + ln) * 16u + 8 + h];
      const float xx = da + p.dt_bias[h]; const float sp = (xx > 20.f) ? xx : __logf(1.f + __expf(xx));
      float gg = -__expf(p.a_log[h]) * sp;
#pragma unroll
      for (int o = 1; o < 64; o <<= 1) { const float tt = BPERM((ln - o) & 63, gg); if (ln >= o) gg += tt; }
      tab[ln] = gg; tab[64 + ln] = sigmoidf_(db); gclast = __builtin_bit_cast(float, __builtin_amdgcn_readlane(__builtin_bit_cast(int, gg), 63));
      if ((NCM & 32) && ln == 63) GL[unit] = __expf(gg); }
#ifndef CPW
#define CPW 255
#endif
    f32x4 A[10]; u32x4 raw[5];
    const unsigned rowbase = (unsigned)row0 - 3u; const int kcol0 = 1024 + h * 128, qcol0 = h * 128, vcol0 = 2048 + h * 128;
    raw_issue(raw, DQKV, rowbase, n * 64, kcol0, ln);
    { f32x4 gq[10];
#pragma unroll
      for (int i = 0; i < 10; ++i) { A[i] = (f32x4){0.f, 0.f, 0.f, 0.f}; gq[i] = (f32x4){0.f, 0.f, 0.f, 0.f}; }
      float ssk[4] = {0.f, 0.f, 0.f, 0.f}, ssq[4] = {0.f, 0.f, 0.f, 0.f};
#pragma unroll 1
      for (int ks = 0; ks < 4; ++ks) {
        bf16x8 kc[4], qc[4];
        { const int col = 1024 + h * 128 + 32 * ks + 8 * fq; f32x4 w[4][2]; load_convw(p.conv_w, col, w);
          raw_commit(wl + CW_RAW, raw, ln); raw_issue(raw, DQKV, rowbase, n * 64, qcol0 + 32 * ks, ln);
#pragma unroll
          for (int rt = 0; rt < 4; ++rt) { float y[8]; conv8l(wl + CW_RAW, 16 * rt + fr, fq, w, y);
#pragma unroll
            for (int e = 0; e < 8; ++e) ssk[rt] += y[e] * y[e];
            kc[rt] = pack_y(y, 1.f); __builtin_amdgcn_sched_barrier(0); } }
        __builtin_amdgcn_sched_barrier(0);
        { const int col = h * 128 + 32 * ks + 8 * fq; f32x4 w[4][2]; load_convw(p.conv_w, col, w);
          raw_commit(wl + CW_RAW, raw, ln); raw_issue(raw, DQKV, rowbase, n * 64, (ks < 3) ? kcol0 + 32 * (ks + 1) : vcol0, ln);
#pragma unroll
          for (int rt = 0; rt < 4; ++rt) { float y[8]; conv8l(wl + CW_RAW, 16 * rt + fr, fq, w, y);
#pragma unroll
            for (int e = 0; e < 8; ++e) ssq[rt] += y[e] * y[e];
            qc[rt] = pack_y(y, 1.f);
            { const int lq = lane_id(); if (NCM & 1) *(bf16x8*)(Qg + (((unsigned)trow0 + 16 * rt + (lq & 15)) * 128u + 32 * ks + 8 * (lq >> 4))) = qc[rt]; } __builtin_amdgcn_sched_barrier(0); } }
        __builtin_amdgcn_sched_barrier(0);
#pragma unroll
        for (int rt = 0; rt < 4; ++rt)
#pragma unroll
          for (int ct = 0; ct <= rt; ++ct) { A[TRI(rt, ct)] = MFMA16(kc[rt], kc[ct], A[TRI(rt, ct)]); gq[TRI(rt, ct)] = MFMA16(qc[rt], kc[ct], gq[TRI(rt, ct)]); }
        __builtin_amdgcn_sched_barrier(0);
      }
      int lnr_ = lane_id(); unsigned wlru = (unsigned)(size_t)lds + (unsigned)(wave * CW_WAVE); asm volatile("" : "+s"(wlru));
      { const int ln = lnr_, fr = ln & 15, fq = ln >> 4; const lds_t wl = (lds_t)(size_t)wlru; LAS float* tab = (LAS float*)(wl + CW_TAB);
#pragma unroll
      for (int rt = 0; rt < 4; ++rt) { float s = ssk[rt]; s += BPERM(ln ^ 16, s); s += BPERM(ln ^ 32, s); float q = ssq[rt]; q += BPERM(ln ^ 16, q); q += BPERM(ln ^ 32, q);
        const float rq = 0.08838834764831845f / sqrtf(q + 1e-6f);
        if (fq == 0) { tab[128 + 16 * rt + fr] = 1.f / sqrtf(s + 1e-6f); tab[192 + 16 * rt + fr] = rq; if (NCM & 1) QS[(unsigned)trow0 + 16 * rt + fr] = rq * __expf(tab[16 * rt + fr]); } }
      }
      asm volatile("" ::: "memory");
      { int lns_ = lane_id(); const int fr = lns_ & 15, fq = lns_ >> 4; unsigned wlsu = (unsigned)(size_t)lds + (unsigned)(wave * CW_WAVE); asm volatile("" : "+s"(wlsu)); const lds_t wl = (lds_t)(size_t)wlsu; LAS float* tab = (LAS float*)(wl + CW_TAB);
#pragma unroll
      for (int rt = 0; rt < 4; ++rt) {
        float gcr[4], ber[4], rkr[4], rqr[4];
#pragma unroll
        for (int j = 0; j < 4; ++j) { const int c = 16 * rt + 4 * fq + j; gcr[j] = tab[c]; ber[j] = tab[64 + c]; rkr[j] = tab[128 + c]; rqr[j] = tab[192 + c]; }
#pragma unroll
        for (int ct = 0; ct < 4; ++ct) {
          bf16_t* qko = QK + (((unsigned)unit * 64 + 16 * rt + 4 * fq) * 64u + 16 * ct + fr);
          if (ct > rt) {
#pragma unroll
            for (int j = 0; j < 4; ++j) { if (NCM & 2) qko[j * 64] = 0; *(LAS float*)(wl + CW_AT + ((16 * ct + fr) * 68 + 16 * rt + 4 * fq + j) * 4) = 0.f; }
            continue; }
          const int s = 16 * ct + fr; const float gs = tab[s], rks = tab[128 + s];
#pragma unroll
          for (int j = 0; j < 4; ++j) { const int c = 16 * rt + 4 * fq + j; const float dec = __expf(gcr[j] - gs) * rks;
            A[TRI(rt, ct)][j] = (c > s) ? A[TRI(rt, ct)][j] * rkr[j] * ber[j] * dec : 0.f;
            *(LAS float*)(wl + CW_AT + (s * 68 + c) * 4) = A[TRI(rt, ct)][j];
            if (NCM & 2) qko[j * 64] = (bf16_t)f2bf((c >= s) ? gq[TRI(rt, ct)][j] * rqr[j] * dec : 0.f); } } }
      }
    }
    __builtin_amdgcn_sched_barrier(0);
#if CPW & 4
    { float t[64]; const int ln = lane_id();
#pragma unroll
      for (int i = 0; i < 64; ++i) t[i] = (ln == i) ? 1.f : 0.f;
      asm volatile("" ::: "memory");
      { unsigned abase = (unsigned)(size_t)(wl + CW_AT); asm volatile("" : "+v"(abase)); subst_rows<0>(t, abase); }
      asm volatile("" ::: "memory");
#pragma unroll
      for (int i = 0; i < 64; ++i) *(LAS bf16_t*)(wl + CW_TB + i * 144 + ln * 2) = (bf16_t)f2bf(t[i]);
      asm volatile("" ::: "memory"); }
#endif
    __builtin_amdgcn_sched_barrier(0);
    int ln8 = lane_id(); { const int fr = ln8 & 15, fq = ln8 >> 4; unsigned wl8u = (unsigned)(size_t)lds + (unsigned)(wave * CW_WAVE); asm volatile("" : "+s"(wl8u)); const lds_t wl = (lds_t)(size_t)wl8u; LAS float* tab = (LAS float*)(wl + CW_TAB);
    bf16x8 ta[4][2];
#pragma unroll
    for (int rt = 0; rt < 4; ++rt) { ta[rt][0] = lds_ld16(wl + CW_TB + (16 * rt + fr) * 144 + fq * 16); ta[rt][1] = lds_ld16(wl + CW_TB + (16 * rt + fr) * 144 + 64 + fq * 16); }
    lds_t chw = wl + CW_CH + fr * 80 + fq * 16;
    lds_t chr = wl + CW_CH + (8 * fq + (fr >> 2)) * 80 + (fr & 3) * 8;
#if CPW & 1
#pragma unroll 1
    for (int ks = 0; ks < 4; ++ks) { const int col = 2048 + h * 128 + 32 * ks + 8 * fq; f32x4 w[4][2]; load_convw(p.conv_w, col, w);
      raw_commit(wl + CW_RAW, raw, ln8); raw_issue(raw, DQKV, rowbase, n * 64, (ks < 3) ? vcol0 + 32 * (ks + 1) : kcol0, ln8);
#pragma unroll
      for (int rt = 0; rt < 4; ++rt) { float y[8]; conv8l(wl + CW_RAW, 16 * rt + fr, fq, w, y);
        *(LAS bf16x8*)(chw + rt * 1280) = pack_y(y, tab[64 + 16 * rt + fr]); if (rt & 1) __builtin_amdgcn_sched_barrier(0); }
      asm volatile("" ::: "memory");
#pragma unroll
      for (int ct2 = 0; ct2 < 2; ++ct2) {
        const s16x4 l0 = lds_tr(chr + ct2 * 32), h0 = lds_tr(chr + 320 + ct2 * 32), l1 = lds_tr(chr + 2560 + ct2 * 32), h1 = lds_tr(chr + 2880 + ct2 * 32);
        const bf16x8 b0 = __builtin_shufflevector(l0, h0, 0, 1, 2, 3, 4, 5, 6, 7), b1 = __builtin_shufflevector(l1, h1, 0, 1, 2, 3, 4, 5, 6, 7);
#pragma unroll
        for (int rt = 0; rt < 4; ++rt) { f32x4 acc = {0.f, 0.f, 0.f, 0.f}; acc = MFMA16(ta[rt][0], b0, acc); acc = MFMA16(ta[rt][1], b1, acc);
          { u32x2 uv2; uv2.x = pk2(acc[0], acc[1]); uv2.y = pk2(acc[2], acc[3]);
            if (NCM & 4) *(u32x2*)(Ug + ((((unsigned)unit * 4 + ks) * 4 + rt) * 64 + ln8) * 8u + ct2 * 4) = uv2; } } }
      __builtin_amdgcn_sched_barrier(0); }
#endif
    __builtin_amdgcn_sched_barrier(0);
#if CPW & 2
#pragma unroll 1
    for (int ks = 0; ks < 4; ++ks) { const int col = 1024 + h * 128 + 32 * ks + 8 * fq; f32x4 w[4][2]; load_convw(p.conv_w, col, w);
      bf16x8 kd[4];
      raw_commit(wl + CW_RAW, raw, ln8); if (ks < 3) raw_issue(raw, DQKV, rowbase, n * 64, kcol0 + 32 * (ks + 1), ln8);
#pragma unroll
      for (int rt = 0; rt < 4; ++rt) { float y[8]; conv8l(wl + CW_RAW, 16 * rt + fr, fq, w, y);
        const int c = 16 * rt + fr; const float gc = tab[c], rk = tab[128 + c];
        *(LAS bf16x8*)(chw + rt * 1280) = pack_y(y, rk * tab[64 + c] * __expf(gc)); kd[rt] = pack_y(y, rk * __expf(gclast - gc)); if (rt & 1) __builtin_amdgcn_sched_barrier(0); }
      asm volatile("" ::: "memory");
#pragma unroll
      for (int ct2 = 0; ct2 < 2; ++ct2) {
        const s16x4 l0 = lds_tr(chr + ct2 * 32), h0 = lds_tr(chr + 320 + ct2 * 32), l1 = lds_tr(chr + 2560 + ct2 * 32), h1 = lds_tr(chr + 2880 + ct2 * 32);
        const bf16x8 b0 = __builtin_shufflevector(l0, h0, 0, 1, 2, 3, 4, 5, 6, 7), b1 = __builtin_shufflevector(l1, h1, 0, 1, 2, 3, 4, 5, 6, 7);
#pragma unroll
        for (int rt = 0; rt < 4; ++rt) { f32x4 acc = {0.f, 0.f, 0.f, 0.f}; acc = MFMA16(b0, ta[rt][0], acc); acc = MFMA16(b1, ta[rt][1], acc);
          u32x2 wv2; wv2.x = pk2(acc[0], acc[1]); wv2.y = pk2(acc[2], acc[3]);
          if (NCM & 8) *(u32x2*)(Wg + (((unsigned)trow0 + 16 * rt + fr) * 128u + 32 * ks + 16 * ct2 + 4 * fq)) = wv2; } }
      asm volatile("" ::: "memory");
#pragma unroll
      for (int rt = 0; rt < 4; ++rt) *(LAS bf16x8*)(chw + rt * 1280) = kd[rt];
      asm volatile("" ::: "memory");
#pragma unroll
      for (int ct2 = 0; ct2 < 2; ++ct2)
#pragma unroll
        for (int ks2 = 0; ks2 < 2; ++ks2) { const s16x4 lo = lds_tr(chr + ks2 * 2560 + ct2 * 32), hi = lds_tr(chr + ks2 * 2560 + 320 + ct2 * 32);
          if (NCM & 16) *(bf16x8*)(KDT + (((unsigned)unit * 128 + 32 * ks + 16 * ct2 + fr) * 64u + 32 * ks2 + 8 * fq)) = __builtin_shufflevector(lo, hi, 0, 1, 2, 3, 4, 5, 6, 7); }
      asm volatile("" ::: "memory"); __builtin_amdgcn_sched_barrier(0); }
#endif
    }
  }
}
constexpr int SC_ST = 0  , SC_VT = 8704  ;
template <int LMUL> DI void scan_phase(const Params& p, lds_t lds, int wv) { TIDS();
  unsigned char* ws = p.ws;
  const bf16_t* QD = (const bf16_t*)(ws + WS_QD); const bf16_t* KDT = (const bf16_t*)(ws + WS_KDT); const bf16_t* Ug = (const bf16_t*)(ws + WS_U); const bf16_t* Wg = (const bf16_t*)(ws + WS_W);
  const bf16_t* QK = (const bf16_t*)((const unsigned char*)p.out + DO_QK); const float* GL = (const float*)(ws + WS_GL); bf16_t* ORAW = (bf16_t*)(ws + WS_ORAW); const float* QS = (const float*)(ws + WS_QS);
  const int fr = lane & 15, fq = lane >> 4, rt = wave & 3;
  for (int unit0 = blockIdx.x; unit0 < 256; unit0 += gridDim.x) {
    const int unit = (gridDim.x == 256) ? ((((unit0 & 7) * 8 + (unit0 >> 5)) << 2) | ((unit0 >> 3) & 3)) : unit0;
    const int bh = unit >> 2, sl = unit & 3, b = bh >> 3, h = bh & 7;
    __syncthreads();
    for (int i = tid; i < (8704 + 4608) / 4; i += 512) ((LAS unsigned*)lds)[i] = 0u;
    f32x4 sacc[2] = {{0.f, 0.f, 0.f, 0.f}, {0.f, 0.f, 0.f, 0.f}};
    const bf16_t* arow = (wave < 4 ? Wg : QD) + ((size_t)bh * L_ + 16 * rt + fr) * 128 + fq * 8;
    const bf16_t* krow = KDT + ((size_t)bh * 64 * 128 + 16 * wave + fr) * 64 + fq * 8;
    const bf16_t* qkrow = QK + ((size_t)bh * 64 * 64 + 16 * rt + fr) * 64 + fq * 8;
    const size_t qkstep = (wave >= 4) ? 4096 : 0, ustep = (wave < 4) ? 8192 : 0, qsstep = (wave >= 4) ? 64 : 0;
    const bf16_t* urow = Ug + ((size_t)((bh * 64) * 4 + sl) * 4 + rt) * 512 + lane * 8;
    const float* qsrow = QS + (size_t)bh * L_ + 16 * rt + 4 * fq;
    bf16_t* orow = ORAW + ((size_t)b * L_ + 16 * rt + 4 * fq) * 1024 + h * 128 + sl * 32 + fr;
    bf16_t* obase = (wave >= 4) ? orow : (bf16_t*)(ws + 54 * MiB) + ((size_t)blockIdx.x * 4 + wave) * 2048 + 32 * fq + fr;     const size_t ostep = (wave >= 4) ? 65536 : 0;
#define SC_DECL(B) bf16x8 B##af[4], B##kf[2], B##qk[2]; u32x4 B##uq; f32x4 B##qs; float B##gl
#define SC_LOADB(B, nn0) do { const int nn = (nn0) * LMUL; _Pragma("unroll") for (int ks = 0; ks < 4; ++ks) B##af[ks] = *(const bf16x8*)(arow + (size_t)(nn) * 8192 + ks * 32); \
      _Pragma("unroll") for (int ks = 0; ks < 2; ++ks) { B##kf[ks] = *(const bf16x8*)(krow + (size_t)(nn) * 8192 + ks * 32); B##qk[ks] = *(const bf16x8*)(qkrow + (size_t)(nn) * qkstep + ks * 32); } \
      B##uq = *(const u32x4*)(urow + (size_t)(nn) * ustep); \
      B##qs = *(const f32x4*)(qsrow + (size_t)(nn) * qsstep); \
      B##gl = __builtin_bit_cast(float, __builtin_amdgcn_readlane(__builtin_bit_cast(int, glv), (nn))); } while (0)
#define SC_BAR() do { asm volatile("s_waitcnt lgkmcnt(0)" ::: "memory"); __builtin_amdgcn_s_barrier(); asm volatile("" ::: "memory"); } while (0)
#define SC_STEP(B, nn) do { \
      f32x4 acc[2]; bf16x8 sb[2][4]; \
      _Pragma("unroll") for (int ct = 0; ct < 2; ++ct) { acc[ct] = (f32x4){0.f, 0.f, 0.f, 0.f}; lds_t sp = lds + SC_ST + (16 * ct + fr) * 272 + fq * 16; \
        _Pragma("unroll") for (int ks = 0; ks < 4; ++ks) sb[ct][ks] = lds_ld16(sp + ks * 64); } \
      __builtin_amdgcn_sched_barrier(0); \
      _Pragma("unroll") for (int ks = 0; ks < 4; ++ks) { acc[0] = MFMA16(B##af[ks], sb[0][ks], acc[0]); acc[1] = MFMA16(B##af[ks], sb[1][ks], acc[1]); } \
      __builtin_amdgcn_sched_barrier(0); \
      if (wave < 4) { \
        { u32x2 v; v.x = pk2(bflo(B##uq.x) - acc[0][0], bfhi(B##uq.x) - acc[0][1]); v.y = pk2(bflo(B##uq.y) - acc[0][2], bfhi(B##uq.y) - acc[0][3]); \
          *(LAS u32x2*)(lds + SC_VT + fr * 144 + (16 * rt + 4 * fq) * 2) = v; \
          v.x = pk2(bflo(B##uq.z) - acc[1][0], bfhi(B##uq.z) - acc[1][1]); v.y = pk2(bflo(B##uq.w) - acc[1][2], bfhi(B##uq.w) - acc[1][3]); \
          *(LAS u32x2*)(lds + SC_VT + (16 + fr) * 144 + (16 * rt + 4 * fq) * 2) = v; } } \
      SC_BAR(); \
      bf16x8 vb[2][2]; \
      _Pragma("unroll") for (int ct = 0; ct < 2; ++ct) _Pragma("unroll") for (int ks = 0; ks < 2; ++ks) vb[ct][ks] = lds_ld16(lds + SC_VT + (16 * ct + fr) * 144 + ks * 64 + fq * 16); \
      { bf16_t* op = obase + (size_t)(nn) * ostep;     \
        _Pragma("unroll") for (int ct = 0; ct < 2; ++ct) { \
          _Pragma("unroll") for (int j = 0; j < 4; ++j) acc[ct][j] *= B##qs[j]; \
          _Pragma("unroll") for (int ks = 0; ks < 2; ++ks) acc[ct] = MFMA16(B##qk[ks], vb[ct][ks], acc[ct]); \
          _Pragma("unroll") for (int j = 0; j < 4; ++j) op[(size_t)j * 1024 + ct * 16] = (bf16_t)f2bf(acc[ct][j]); } } \
      _Pragma("unroll") for (int ct = 0; ct < 2; ++ct) { sacc[ct] = sacc[ct] * B##gl; \
        _Pragma("unroll") for (int ks = 0; ks < 2; ++ks) sacc[ct] = MFMA16(B##kf[ks], vb[ct][ks], sacc[ct]); \
        u32x2 v; v.x = pk2(sacc[ct][0], sacc[ct][1]); v.y = pk2(sacc[ct][2], sacc[ct][3]); \
        *(LAS u32x2*)(lds + SC_ST + (16 * ct + fr) * 272 + (16 * wave + 4 * fq) * 2) = v; } \
      if ((nn) + 3 < 64) SC_LOADB(B, (nn) + 3); \
      SC_BAR(); } while (0)
    const float glv = GL[bh * 64 + lane];
    SC_DECL(b0); SC_DECL(b1); SC_DECL(b2);
    SC_LOADB(b0, 0); SC_LOADB(b1, 1); SC_LOADB(b2, 2);
    __syncthreads();
    for (int n = 0; n < 63; n += 3) { SC_STEP(b0, n); SC_STEP(b1, n + 1); SC_STEP(b2, n + 2); }
    SC_STEP(b0, 63);
#undef SC_DECL
#undef SC_LOADB
#undef SC_BAR
#undef SC_STEP
  }
}
DI void gate_phase(const Params& p, int wv) { TIDS();
  const bf16_t* ORAW = (const bf16_t*)(p.ws + WS_ORAW); const bf16_t* ZG = (const bf16_t*)(p.ws + WS_ZG); bf16_t* OA = (bf16_t*)(p.ws + WS_OA);
  const int fr = tid & 15;
  const f32x4 w0 = *(const f32x4*)(p.dn_norm_w + fr * 8), w1 = *(const f32x4*)(p.dn_norm_w + fr * 8 + 4);
  for (size_t it = (size_t)blockIdx.x * 512 + tid; it < (size_t)T_ * 128; it += (size_t)gridDim.x * 512) {
    const size_t off = it * 8;
    const u32x4 q = *(const u32x4*)(ORAW + off);
    const f32x4 a0 = {bflo(q.x), bfhi(q.x), bflo(q.y), bfhi(q.y)}, a1 = {bflo(q.z), bfhi(q.z), bflo(q.w), bfhi(q.w)};
    float ss = (a0[0] * a0[0] + a0[1] * a0[1]) + (a0[2] * a0[2] + a0[3] * a0[3]) + (a1[0] * a1[0] + a1[1] * a1[1]) + (a1[2] * a1[2] + a1[3] * a1[3]);
    ss = sum16(ss, lane);
    const float r = 1.f / sqrtf(ss * (1.f / 128.f) + 1e-6f);
    const size_t row = it >> 7; const int col = (int)(it & 127) * 8;
    const u32x4 z = *(const u32x4*)(ZG + row * 3072 + col);
    u32x4 o;
    o.x = pk2(a0[0] * r * w0[0] * siluf_(bflo(z.x)), a0[1] * r * w0[1] * siluf_(bfhi(z.x)));
    o.y = pk2(a0[2] * r * w0[2] * siluf_(bflo(z.y)), a0[3] * r * w0[3] * siluf_(bfhi(z.y)));
    o.z = pk2(a1[0] * r * w1[0] * siluf_(bflo(z.z)), a1[1] * r * w1[1] * siluf_(bfhi(z.z)));
    o.w = pk2(a1[2] * r * w1[2] * siluf_(bflo(z.w)), a1[3] * r * w1[3] * siluf_(bfhi(z.w)));
    *(u32x4*)(OA + off) = o;
  }
}
constexpr size_t WS_X2B = S5;
DI void final_norm_phase(const Params& p, int wv) { TIDS();
  const int gw = blockIdx.x * 8 + wave, NGW = gridDim.x * 8;
  const bf16_t* X2 = (const bf16_t*)(p.ws + WS_X2B);
  const f32x4* wr = (const f32x4*)p.final_norm_w + lane * 2;
  const f32x4 g0 = wr[0], g1 = wr[1], g2 = wr[128], g3 = wr[129];
  for (int m = gw; m < T_; m += 2 * NGW) { const int m2 = (m + NGW < T_) ? m + NGW : m;
    const u32x4 a0 = *((const u32x4*)(X2 + (size_t)m * D_) + lane), a1 = *((const u32x4*)(X2 + (size_t)m * D_) + 64 + lane);
    const u32x4 b0 = *((const u32x4*)(X2 + (size_t)m2 * D_) + lane), b1 = *((const u32x4*)(X2 + (size_t)m2 * D_) + 64 + lane);
    const f32x4 va0 = {bflo(a0.x), bfhi(a0.x), bflo(a0.y), bfhi(a0.y)}, va1 = {bflo(a0.z), bfhi(a0.z), bflo(a0.w), bfhi(a0.w)}, va2 = {bflo(a1.x), bfhi(a1.x), bflo(a1.y), bfhi(a1.y)}, va3 = {bflo(a1.z), bfhi(a1.z), bflo(a1.w), bfhi(a1.w)};
    const f32x4 vb0 = {bflo(b0.x), bfhi(b0.x), bflo(b0.y), bfhi(b0.y)}, vb1 = {bflo(b0.z), bfhi(b0.z), bflo(b0.w), bfhi(b0.w)}, vb2 = {bflo(b1.x), bfhi(b1.x), bflo(b1.y), bfhi(b1.y)}, vb3 = {bflo(b1.z), bfhi(b1.z), bflo(b1.w), bfhi(b1.w)};
    const f32x4 qa = va0 * va0 + va1 * va1 + va2 * va2 + va3 * va3, qb = vb0 * vb0 + vb1 * vb1 + vb2 * vb2 + vb3 * vb3;
    const float ra = 1.f / sqrtf(wave_sum((qa[0] + qa[1]) + (qa[2] + qa[3]), lane) * (1.f / 1024.f) + 1e-6f), rb = 1.f / sqrtf(wave_sum((qb[0] + qb[1]) + (qb[2] + qb[3]), lane) * (1.f / 1024.f) + 1e-6f);
    f32x4* oa = (f32x4*)(p.out + (size_t)m * D_) + lane * 2; f32x4* ob = (f32x4*)(p.out + (size_t)m2 * D_) + lane * 2;
    oa[0] = va0 * ra * g0; oa[1] = va1 * ra * g1; oa[128] = va2 * ra * g2; oa[129] = va3 * ra * g3;
    ob[0] = vb0 * rb * g0; ob[1] = vb1 * rb * g1; ob[128] = vb2 * rb * g2; ob[129] = vb3 * rb * g3; }
}
DI void norm2_phase(const Params& p, int wv) { TIDS();
  const int gw = blockIdx.x * 8 + wave, NGW = gridDim.x * 8;
  const bf16_t* X1 = (const bf16_t*)(p.ws + WS_X1); bf16_t* H2 = (bf16_t*)(p.ws + WS_H2);
  const f32x4* wr = (const f32x4*)p.norm2_w + lane * 2;
  const f32x4 g0 = wr[0], g1 = wr[1], g2 = wr[128], g3 = wr[129];
  for (int m = gw; m < T_; m += 2 * NGW) { const int m2 = (m + NGW < T_) ? m + NGW : m;
    const u32x4 a0 = *((const u32x4*)(X1 + (size_t)m * D_) + lane), a1 = *((const u32x4*)(X1 + (size_t)m * D_) + 64 + lane);
    const u32x4 b0 = *((const u32x4*)(X1 + (size_t)m2 * D_) + lane), b1 = *((const u32x4*)(X1 + (size_t)m2 * D_) + 64 + lane);
    float va[16], vb[16];
#define UNP(dst, o, q) dst[o] = bflo(q.x); dst[o + 1] = bfhi(q.x); dst[o + 2] = bflo(q.y); dst[o + 3] = bfhi(q.y); dst[o + 4] = bflo(q.z); dst[o + 5] = bfhi(q.z); dst[o + 6] = bflo(q.w); dst[o + 7] = bfhi(q.w)
    UNP(va, 0, a0); UNP(va, 8, a1); UNP(vb, 0, b0); UNP(vb, 8, b1);
#undef UNP
    float sa = 0.f, sb = 0.f;
#pragma unroll
    for (int e = 0; e < 16; ++e) { sa += va[e] * va[e]; sb += vb[e] * vb[e]; }
    const float ra = 1.f / sqrtf(wave_sum(sa, lane) * (1.f / 1024.f) + 1e-6f), rb = 1.f / sqrtf(wave_sum(sb, lane) * (1.f / 1024.f) + 1e-6f);
    const float gg[16] = {g0[0], g0[1], g0[2], g0[3], g1[0], g1[1], g1[2], g1[3], g2[0], g2[1], g2[2], g2[3], g3[0], g3[1], g3[2], g3[3]};
    u32x4 oa0, oa1, ob0, ob1;
    oa0.x = pk2(va[0] * ra * gg[0], va[1] * ra * gg[1]); oa0.y = pk2(va[2] * ra * gg[2], va[3] * ra * gg[3]); oa0.z = pk2(va[4] * ra * gg[4], va[5] * ra * gg[5]); oa0.w = pk2(va[6] * ra * gg[6], va[7] * ra * gg[7]);
    oa1.x = pk2(va[8] * ra * gg[8], va[9] * ra * gg[9]); oa1.y = pk2(va[10] * ra * gg[10], va[11] * ra * gg[11]); oa1.z = pk2(va[12] * ra * gg[12], va[13] * ra * gg[13]); oa1.w = pk2(va[14] * ra * gg[14], va[15] * ra * gg[15]);
    ob0.x = pk2(vb[0] * rb * gg[0], vb[1] * rb * gg[1]); ob0.y = pk2(vb[2] * rb * gg[2], vb[3] * rb * gg[3]); ob0.z = pk2(vb[4] * rb * gg[4], vb[5] * rb * gg[5]); ob0.w = pk2(vb[6] * rb * gg[6], vb[7] * rb * gg[7]);
    ob1.x = pk2(vb[8] * rb * gg[8], vb[9] * rb * gg[9]); ob1.y = pk2(vb[10] * rb * gg[10], vb[11] * rb * gg[11]); ob1.z = pk2(vb[12] * rb * gg[12], vb[13] * rb * gg[13]); ob1.w = pk2(vb[14] * rb * gg[14], vb[15] * rb * gg[15]);
    *((u32x4*)(H2 + (size_t)m * D_) + lane) = oa0; *((u32x4*)(H2 + (size_t)m * D_) + 64 + lane) = oa1;
    *((u32x4*)(H2 + (size_t)m2 * D_) + lane) = ob0; *((u32x4*)(H2 + (size_t)m2 * D_) + 64 + lane) = ob1; }
}
#define GEMM_PHASE(EpiT, Aptr, Bptr, Nn, Kk, ...) do { pg8::Gemm g_{(const bf16_t*)(Aptr), (const bf16_t*)(Bptr), T_, (Nn), (Kk), wv}; pg8::StaticOrder S_; S_.init(T_, (Nn), (int)gridDim.x, (int)blockIdx.x); \
    EpiT E_{__VA_ARGS__}; pg8::gemm_phase<EpiT, pg8::StaticOrder, PG8_ALIGN, PG8_SP2>((PG8_LAS unsigned char*)lds, g_, S_, E_); } while (0)
#ifndef REP_P0
#define REP_P0 1
#endif
#ifndef REP_ATTN
#define REP_ATTN 1
#endif
#ifndef REP_CP
#define REP_CP 1
#endif
#ifndef REP_SCAN
#define REP_SCAN 1
#endif
#ifndef REP_EW
#define REP_EW 1
#endif
#ifndef REP_GEMM
#define REP_GEMM 1
#endif
#define XB_TMO      128
#define XB_XCNT(j)  (256  + 64 * (j))
#define XB_XSUB(j)  (1280 + 64 * (j))
#define XB_XGEN(j)  (2304 + 64 * (j))
#define XB_TOP      3328
#define XB_TOPGEN   3392
#define XCD_BAR_WORDS 3456
#define XB_SPIN_CAP (1u << 18)

__device__ __forceinline__ unsigned xb_ld(unsigned* p)              { return __hip_atomic_load(p, __ATOMIC_RELAXED, __HIP_MEMORY_SCOPE_AGENT); }
__device__ __forceinline__ unsigned xb_add(unsigned* p, unsigned v) { return __hip_atomic_fetch_add(p, v, __ATOMIC_RELAXED, __HIP_MEMORY_SCOPE_AGENT); }
__device__ __forceinline__ unsigned xb_xcc_id() { return (unsigned)__builtin_amdgcn_s_getreg((3 << 11) | 20) & 0xFu; }
#define XB_SPIN(cond, bar) do { unsigned _sp = 0; while (cond) { __builtin_amdgcn_s_sleep(1); \
    if ((++_sp & 255u) == 0u) { if (xb_ld(&(bar)[XB_TMO])) break; if (_sp > XB_SPIN_CAP) { atomicAdd(&(bar)[XB_TMO], 1u); break; } } } } while (0)

struct XcdBarrier {
    int wv;
    unsigned* bar; unsigned x;
    volatile LAS unsigned* st;
};

__device__ __forceinline__ XcdBarrier xcd_barrier_post(unsigned* bar, volatile LAS unsigned* st) {
    XcdBarrier b; b.bar = bar; b.x = xb_xcc_id(); b.st = st; b.wv = 0;
    if (threadIdx.x == 0) (void)xb_add(&bar[XB_XCNT(b.x)], 1u);
    return b;
}
__device__ __forceinline__ void xcd_barrier_complete(unsigned* bar, unsigned x, unsigned& nloc, unsigned& nx) {
    const unsigned G = gridDim.x * gridDim.y * gridDim.z;
    unsigned sum, cnt, mine, sp = 0u;
    for (;;) {
        sum = 0u; cnt = 0u; mine = 0u;
#pragma unroll
        for (unsigned j = 0; j < 16; ++j) { const unsigned c = xb_ld(&bar[XB_XCNT(j)]); sum += c; cnt += (c > 0u) ? 1u : 0u; mine = (j == x) ? c : mine; }
        if (sum == G) break;
        __builtin_amdgcn_s_sleep(1);
        if ((++sp & 255u) == 0u) { if (xb_ld(&bar[XB_TMO])) break; if (sp > XB_SPIN_CAP) { atomicAdd(&bar[XB_TMO], 1u); break; } }
    }
    nloc = mine > 0u ? mine : 1u; nx = cnt > 0u ? cnt : 1u;
}

__device__ __forceinline__ void xcd_barrier(const XcdBarrier& b) {
    asm volatile("s_waitcnt vmcnt(0)" ::: "memory");
    __syncthreads();
    if (b.wv == 0 && lane_id() == 0) {
        unsigned* bar = b.bar;
        __builtin_amdgcn_s_waitcnt(0);
        unsigned nloc = b.st[0], nx = b.st[1];
        if (nloc == 0u) { xcd_barrier_complete(bar, b.x, nloc, nx); b.st[0] = nloc; b.st[1] = nx; }
        const unsigned old = xb_add(&bar[XB_XSUB(b.x)], 1u);
        const unsigned gen = old / nloc;
        if (old + 1u == (gen + 1u) * nloc) {
            __builtin_amdgcn_fence(__ATOMIC_RELEASE, "agent");
            asm volatile("s_waitcnt vmcnt(0)" ::: "memory");
            const unsigned og = xb_add(&bar[XB_TOP], 1u);
            const unsigned tg = og / nx;
            if (og + 1u == (tg + 1u) * nx) xb_add(&bar[XB_TOPGEN], 1u);
            else XB_SPIN(xb_ld(&bar[XB_TOPGEN]) == tg, bar);
            __builtin_amdgcn_fence(__ATOMIC_ACQUIRE, "agent");
            xb_add(&bar[XB_XGEN(b.x)], 1u);
            asm volatile("s_waitcnt vmcnt(0)" ::: "memory");
        } else {
            XB_SPIN(xb_ld(&bar[XB_XGEN(b.x)]) == gen, bar);
            __builtin_amdgcn_fence(__ATOMIC_ACQUIRE, "agent");
            asm volatile("s_waitcnt vmcnt(0)" ::: "memory");
        }
    }
    __syncthreads();
}

constexpr size_t WS_BAR = 51 * MiB; constexpr int LDS_ST_OFF = 159744 - 256;
typedef const __attribute__((address_space(4))) Params* kparams_t;
DI Params load_params() {
  Params r{};
#if defined(__HIP_DEVICE_COMPILE__)
  kparams_t k = (kparams_t)__builtin_amdgcn_kernarg_segment_ptr(); asm volatile("" : "+s"(k));
  r.x = k->x; r.norm1_w = k->norm1_w; r.w_in = k->w_in; r.conv_w = k->conv_w; r.a_log = k->a_log; r.dt_bias = k->dt_bias; r.dn_norm_w = k->dn_norm_w; r.w_proj_a = k->w_proj_a;
  r.w_proj_b = k->w_proj_b; r.w_out = k->w_out; r.norm2_w = k->norm2_w; r.w_gate_up = k->w_gate_up; r.w_down = k->w_down; r.final_norm_w = k->final_norm_w; r.out = k->out; r.ws = k->ws;
#endif
  return r;
}
#define WSP (p.ws)
#define OBP ((unsigned char*)p.out)
#define WINP ((bf16_t*)(p.ws + WS_WIN))
__global__ void __launch_bounds__(512, 2) fwd_megakernel(Params p_unused) {
  extern __shared__ __attribute__((aligned(16))) unsigned char lds_raw[];
  cg::grid_group grid = cg::this_grid();
  lds_t lds = (lds_t)lds_raw;
  volatile LAS unsigned* st = (volatile LAS unsigned*)(lds + LDS_ST_OFF);
  if (threadIdx.x < 4) st[threadIdx.x] = 0u;
  __syncthreads();
  int wv = __builtin_amdgcn_readfirstlane((int)threadIdx.x >> 6); asm volatile("" : "+s"(wv));
  XcdBarrier bar;
  { const Params p = load_params(); bar = xcd_barrier_post((unsigned*)(p.ws + WS_BAR), st); bar.wv = wv; }
  { const Params p = load_params(); p0_prologue(p, lds, wv); } if (REP_P0 > 1) { const Params p = load_params(); p0_prologue(p, lds, wv); }
  if (wv < 0) grid.sync();
  xcd_barrier(bar);
  { const Params p = load_params(); GEMM_PHASE(EpiRope, OBP + DO_H1, WINP, 4608, 1024, (bf16_t*)(WSP + WS_AQKV), (const float*)(WSP + WS_ROPE)); }
#ifdef REP_G1
  { const Params p = load_params(); GEMM_PHASE(EpiRope, OBP + DO_H1, WINP, 4608, 1024, (bf16_t*)(WSP + WS_AQKV), (const float*)(WSP + WS_ROPE)); }
#endif
  xcd_barrier(bar);
  { const Params p = load_params(); attn_phase(p, lds, wv); } if (REP_ATTN > 1) { const Params p = load_params(); attn_phase(p, lds, wv); }
  xcd_barrier(bar);
  { const Params p = load_params(); combine_phase(p, wv); } if (REP_EW > 1) { const Params p = load_params(); combine_phase(p, wv); }
  { const Params p = load_params(); bg_phase(p, wv); }
  __syncthreads();
  { const Params p = load_params(); GEMM_PHASE(EpiDn, OBP + DO_H1, WINP + (size_t)4608 * 1024, 3072, 1024, (bf16_t*)(WSP + WS_DQKV), (float*)(WSP + WS_BG)); }
  xcd_barrier(bar);
  { const Params p = load_params(); chunkprep_wave(p, lds, wv); } if (REP_CP > 1) { const Params p = load_params(); chunkprep_wave(p, lds, wv); }
  xcd_barrier(bar);
  if (REP_SCAN > 1) { const Params p = load_params(); scan_phase<0>(p, lds, wv); }
  { const Params p = load_params(); scan_phase<1>(p, lds, wv); }
  xcd_barrier(bar);
  { const Params p = load_params(); GEMM_PHASE(EpiZG, OBP + DO_H1, WINP + (size_t)7936 * 1024, 3072, 1024, (bf16_t*)(WSP + WS_ZG)); }
  xcd_barrier(bar);
  { const Params p = load_params(); gate_phase(p, wv); } if (REP_EW > 1) { const Params p = load_params(); gate_phase(p, wv); }
  xcd_barrier(bar);
  { const Params p = load_params(); GEMM_PHASE(EpiYa, WSP + WS_OA, WSP + WS_WPA, 1024, 1024, (bf16_t*)(WSP + WS_PART), (const bf16_t*)(WSP + WS_ZG)); }
  { const Params p = load_params(); GEMM_PHASE(EpiYb, OBP + DO_OB, WSP + WS_WPB, 1024, 512, (const bf16_t*)(WSP + WS_PART), (const bf16_t*)(WSP + WS_ZG), (bf16_t*)(WSP + WS_MERGED)); }
  xcd_barrier(bar);
  { const Params p = load_params(); GEMM_PHASE(EpiResToB, WSP + WS_MERGED, WSP + WS_WOUT, 1024, 1024, p.x, (bf16_t*)(WSP + WS_X1)); }
#ifdef REP_G9
  { const Params p = load_params(); GEMM_PHASE(EpiResToB, WSP + WS_MERGED, WSP + WS_WOUT, 1024, 1024, p.x, (bf16_t*)(WSP + WS_X1)); }
#endif
  xcd_barrier(bar);
  { const Params p = load_params(); norm2_phase(p, wv); } if (REP_EW > 1) { const Params p = load_params(); norm2_phase(p, wv); }
  xcd_barrier(bar);
  { const Params p = load_params(); GEMM_PHASE(EpiSwiglu, WSP + WS_H2, WSP + WS_WGU, 5632, 1024, (bf16_t*)(WSP + WS_ACT)); } if (REP_GEMM > 1) { const Params p = load_params(); GEMM_PHASE(EpiSwiglu, WSP + WS_H2, WSP + WS_WGU, 5632, 1024, (bf16_t*)(WSP + WS_ACT)); }
  xcd_barrier(bar);
  { const Params p = load_params(); GEMM_PHASE(EpiResBB, WSP + WS_ACT, WSP + WS_WDN, 1024, FF_, (const bf16_t*)(WSP + WS_X1), (bf16_t*)(WSP + WS_X2B)); }
#ifdef REP_G12
  { const Params p = load_params(); GEMM_PHASE(EpiResBB, WSP + WS_ACT, WSP + WS_WDN, 1024, FF_, (const bf16_t*)(WSP + WS_X1), (bf16_t*)(WSP + WS_X2B)); }
#endif
  xcd_barrier(bar);
  { const Params p = load_params(); final_norm_phase(p, wv); }
}

extern "C" void kernel_launch(void* const* d_in, const int* in_sizes, int n_in, void* d_out, int out_size, void* d_ws, size_t ws_size, hipStream_t stream) {
  static int grid_blocks = 0;
  if (grid_blocks == 0) {
    if (n_in != 14 || out_size != T_ * D_ || ws_size < 8 * U_) { fprintf(stderr, "kernel_launch: unexpected shapes n_in %d out %d ws %zu\n", n_in, out_size, ws_size); grid_blocks = -1; return; }
    int dev = 0, cus = 0, per_cu = 0;
    (void)hipGetDevice(&dev); (void)hipDeviceGetAttribute(&cus, hipDeviceAttributeMultiprocessorCount, dev);
    if (hipFuncSetAttribute((const void*)fwd_megakernel, hipFuncAttributeMaxDynamicSharedMemorySize, LDS_BYTES) != hipSuccess) { fprintf(stderr, "hipFuncSetAttribute failed\n"); grid_blocks = -1; return; }
    if (hipOccupancyMaxActiveBlocksPerMultiprocessor(&per_cu, (const void*)fwd_megakernel, 512, LDS_BYTES) != hipSuccess || per_cu < 1) { fprintf(stderr, "occupancy query failed (%d)\n", per_cu); per_cu = 1; }
    (void)hipGetLastError();
    grid_blocks = cus * per_cu;
  }
  if (grid_blocks < 0) return;
  if (hipMemsetAsync((unsigned char*)d_ws + WS_BAR, 0, 16384, stream) != hipSuccess) { fprintf(stderr, "memset failed\n"); return; }
  Params p{};
  p.x = (const float*)d_in[0]; p.norm1_w = (const float*)d_in[1]; p.w_in = (const float*)d_in[2]; p.conv_w = (const float*)d_in[3]; p.a_log = (const float*)d_in[4];
  p.dt_bias = (const float*)d_in[5]; p.dn_norm_w = (const float*)d_in[6]; p.w_proj_a = (const float*)d_in[7]; p.w_proj_b = (const float*)d_in[8]; p.w_out = (const float*)d_in[9];
  p.norm2_w = (const float*)d_in[10]; p.w_gate_up = (const float*)d_in[11]; p.w_down = (const float*)d_in[12]; p.final_norm_w = (const float*)d_in[13];
  p.out = (float*)d_out; p.ws = (unsigned char*)d_ws;
  void* args[] = {&p};
  hipError_t e = hipLaunchCooperativeKernel((const void*)fwd_megakernel, dim3(grid_blocks), dim3(512), args, LDS_BYTES, stream);
  if (e != hipSuccess) fprintf(stderr, "cooperative launch failed: %s (grid %d)\n", hipGetErrorString(e), grid_blocks);
}
```

```cpp
#include <hip/hip_runtime.h>
#include <hip/hip_cooperative_groups.h>
#include <cstdio>
#include <cstdint>
namespace cg = cooperative_groups;
namespace pg8 {
#define PG8_LAS __attribute__((address_space(3)))
typedef unsigned short bf16_t;
typedef short bf16x8 __attribute__((ext_vector_type(8)));
typedef float f32x4 __attribute__((ext_vector_type(4)));
typedef unsigned u32x4 __attribute__((ext_vector_type(4)));
constexpr int BM = 256, BK = 64, HALF = 128, HTB = HALF * BK * 2  , STAGE_BYTES = 8 * HTB, NXCD = 8, WGM = 8;

__host__ __device__ __forceinline__ int lds_byte(int r, int c) { const int st = (r >> 4) * 2 + (c >> 5), rr = r & 15, cc = c & 31, ob = rr * 64 + cc * 2; return st * 1024 + (ob ^ (((ob >> 9) & 1) << 5)); }
__host__ __device__ __forceinline__ void stage_rc(int b, int& R, int& C) { const int st = b / 1024, sb = b % 1024, swz = sb ^ (((sb >> 9) & 1) << 5); R = (st >> 1) * 16 + swz / 64; C = (st & 1) * 32 + (swz % 64) / 2; }
__host__ __device__ __forceinline__ int perm32(int rho) { const int n = rho >> 4, i = rho & 15; return 8 * (i >> 2) + 4 * n + (i & 3); }

struct Unit { int pm, pn; };
struct Gemm { const bf16_t* A; const bf16_t* Bt; int M, N, K, wv; };

struct StaticOrder {
    int nM, nN, nwg, G, c;
    __host__ __device__ void init(int M, int N, int G_, int c_) { nM = M / BM; nN = N / BM; nwg = nM * nN; G = G_; c = c_; }
    __host__ __device__ bool next(int i, Unit& u) const {
        const long L = (long)i * G + c; if (L >= nwg) return false;
        int wgid = (int)L; { const int q = nwg / NXCD, r = nwg % NXCD, xcd = wgid % NXCD, off = wgid / NXCD; wgid = (xcd < r ? xcd * (q + 1) : r * (q + 1) + (xcd - r) * q) + off; }
        const int nig = WGM * nN, gid = wgid / nig, fm = gid * WGM, gsz = (nM - fm) < WGM ? (nM - fm) : WGM;
        u.pm = fm + ((wgid % nig) % gsz); u.pn = (wgid % nig) / gsz; return true;
    }
    __device__ __forceinline__ void a_ready(const Unit&) const {}
    __device__ __forceinline__ void done(const Unit&) const {}
};

template <class Epi, class Sched, bool ALIGN_EPI = false, bool SP2 = false>
__device__ __forceinline__ void gemm_phase(PG8_LAS unsigned char* lds, const Gemm g, const Sched& S, const Epi& E) {
    int ln_; asm volatile("v_mbcnt_lo_u32_b32 %0, -1, 0\n\tv_mbcnt_hi_u32_b32 %0, -1, %0" : "=v"(ln_)); int tid_ = (g.wv << 6) | ln_; const int tid = tid_, wid = __builtin_amdgcn_readfirstlane(tid >> 6), lane = tid & 63, wr = wid >> 2, wc = wid & 3, fr = lane & 15, fq = lane >> 4;
    const int K = g.K, nt = K / BK;
    unsigned voffA[2], voffB[2];
#pragma unroll
    for (int i = 0; i < 2; ++i) { int R, C; stage_rc(tid * 16 + i * 8192, R, C); const int Rb = Epi::PERM ? ((R & ~31) + perm32(R & 31)) : R;
        voffA[i] = (unsigned)(R * K + C) * 2u; voffB[i] = (unsigned)(Rb * K + C) * 2u; }
    const size_t kstep = (size_t)(BK * 2);
    const size_t hstep = (size_t)HALF * K * 2;
    const size_t tstep = 2 * hstep;
    const unsigned ldsw = (unsigned)wid * 1024u;
    const int aoff = lds_byte(wr * 64 + fr, fq * 8), boff = lds_byte(wc * 32 + fr, fq * 8);
#define PG8_SA(b, h) (((b) * 2 + (h)) * HTB)
#define PG8_SB(b, h) ((4 + (b) * 2 + (h)) * HTB)
#define PG8_STAGE(bufoff, gbase, voff) do { _Pragma("unroll") for (int _i = 0; _i < 2; ++_i) \
        __builtin_amdgcn_global_load_lds((const unsigned*)((const char*)(gbase) + (voff)[_i]), (PG8_LAS unsigned*)(lds + (bufoff) + ldsw + _i * 8192), 16, 0, 0); } while (0)
#define PG8_LDA(dst, b, h) do { _Pragma("unroll") for (int m = 0; m < 4; ++m) _Pragma("unroll") for (int k = 0; k < 2; ++k) dst[m][k] = *(const PG8_LAS bf16x8*)(lds + PG8_SA(b, h) + aoff + m * 2048 + k * 1024); } while (0)
#define PG8_LDB(dst, b, h) do { _Pragma("unroll") for (int n = 0; n < 2; ++n) _Pragma("unroll") for (int k = 0; k < 2; ++k) dst[n][k] = *(const PG8_LAS bf16x8*)(lds + PG8_SB(b, h) + boff + n * 2048 + k * 1024); } while (0)
#define PG8_MMA(ai, bj, At, Bt) do { __builtin_amdgcn_s_setprio(1); _Pragma("unroll") for (int m = 0; m < 4; ++m) _Pragma("unroll") for (int n = 0; n < 2; ++n) _Pragma("unroll") for (int k = 0; k < 2; ++k) \
        acc[ai][bj][m][n] = __builtin_amdgcn_mfma_f32_16x16x32_bf16(Bt[n][k], At[m][k], acc[ai][bj][m][n], 0, 0, 0); __builtin_amdgcn_s_setprio(0); } while (0)
#define PG8_WAIT_V(n) asm volatile("s_waitcnt vmcnt(" #n ")" ::: "memory")
#define PG8_WAIT_L(n) asm volatile("s_waitcnt lgkmcnt(" #n ")" ::: "memory")
#define PG8_BAR __builtin_amdgcn_s_barrier()
#define PG8_SCHED __builtin_amdgcn_sched_barrier(0)
    Unit cur, nxt; int ui = 0;
    if (!S.next(0, cur)) return;
    f32x4 acc[2][2][4][2];
#pragma unroll
    for (int a = 0; a < 2; ++a)
#pragma unroll
        for (int b = 0; b < 2; ++b)
#pragma unroll
            for (int m = 0; m < 4; ++m)
#pragma unroll
                for (int n = 0; n < 2; ++n) acc[a][b][m][n] = (f32x4){0.f, 0.f, 0.f, 0.f};
    bf16x8 At[4][2], B0[2][2], B1[2][2];
    const char* cA = (const char*)g.A + (size_t)cur.pm * tstep; const char* cB = (const char*)g.Bt + (size_t)cur.pn * tstep;
    S.a_ready(cur);
    if constexpr (SP2) {
        PG8_STAGE(PG8_SB(0, 0), cB, voffB); PG8_STAGE(PG8_SB(0, 1), cB + hstep, voffB); PG8_STAGE(PG8_SA(0, 0), cA, voffA); PG8_STAGE(PG8_SA(0, 1), cA + hstep, voffA);
        if (wr == 1) PG8_BAR;
        PG8_WAIT_V(2); PG8_BAR;
        PG8_STAGE(PG8_SB(1, 0), cB + kstep, voffB); PG8_STAGE(PG8_SA(1, 0), cA + kstep, voffA); PG8_STAGE(PG8_SB(1, 1), cB + hstep + kstep, voffB);
        PG8_WAIT_V(6); PG8_BAR;
    } else {
        PG8_STAGE(PG8_SB(0, 0), cB, voffB); PG8_STAGE(PG8_SA(0, 0), cA, voffA); PG8_STAGE(PG8_SB(0, 1), cB + hstep, voffB); PG8_STAGE(PG8_SA(0, 1), cA + hstep, voffA);
        if (wr == 1) PG8_BAR;
        PG8_WAIT_V(4); PG8_BAR;
        PG8_STAGE(PG8_SB(1, 0), cB + kstep, voffB); PG8_STAGE(PG8_SA(1, 0), cA + kstep, voffA); PG8_STAGE(PG8_SB(1, 1), cB + hstep + kstep, voffB);
        PG8_WAIT_V(6); PG8_BAR;
    }
    for (;;) {
        const bool has_next = S.next(ui + 1, nxt);
        const char* nA = has_next ? (const char*)g.A + (size_t)nxt.pm * tstep : cA; const char* nB = has_next ? (const char*)g.Bt + (size_t)nxt.pn * tstep : cB;
        for (int t = 0; t < nt; t += 2) {
            const bool last = (t == nt - 2);
            const char* a1 = cA + (size_t)(t + 1) * kstep;
            const char* a2 = last ? nA : cA + (size_t)(t + 2) * kstep; const char* b2 = last ? nB : cB + (size_t)(t + 2) * kstep;
            const char* a3 = a2 + kstep; const char* b3 = b2 + kstep;
            if (last && has_next) S.a_ready(nxt);
            if constexpr (SP2) {
            PG8_LDB(B0, 0, 0); PG8_LDB(B1, 0, 1); PG8_SCHED; PG8_LDA(At, 0, 0); PG8_STAGE(PG8_SA(1, 1), a1 + hstep, voffA);
            PG8_WAIT_V(8); PG8_WAIT_L(0); PG8_BAR; PG8_MMA(0, 0, At, B0); PG8_MMA(0, 1, At, B1); PG8_BAR; PG8_SCHED;
            PG8_LDA(At, 0, 1); PG8_STAGE(PG8_SB(0, 0), b2, voffB); PG8_STAGE(PG8_SB(0, 1), b2 + hstep, voffB); PG8_STAGE(PG8_SA(0, 0), a2, voffA);
            PG8_WAIT_V(8); PG8_WAIT_L(0); PG8_BAR; PG8_MMA(1, 0, At, B0); PG8_MMA(1, 1, At, B1); PG8_BAR; PG8_SCHED;
            PG8_LDB(B0, 1, 0); PG8_LDB(B1, 1, 1); PG8_SCHED; PG8_LDA(At, 1, 0); PG8_STAGE(PG8_SA(0, 1), a2 + hstep, voffA);
            PG8_WAIT_V(8); PG8_WAIT_L(0); PG8_BAR; PG8_MMA(0, 0, At, B0); PG8_MMA(0, 1, At, B1); PG8_BAR; PG8_SCHED;
            PG8_LDA(At, 1, 1); PG8_STAGE(PG8_SB(1, 0), b3, voffB); PG8_STAGE(PG8_SB(1, 1), b3 + hstep, voffB); PG8_STAGE(PG8_SA(1, 0), a3, voffA);
            PG8_WAIT_V(8); PG8_WAIT_L(0); PG8_BAR; PG8_MMA(1, 0, At, B0); PG8_MMA(1, 1, At, B1); PG8_BAR; PG8_SCHED;
            } else {
            PG8_LDB(B0, 0, 0); PG8_SCHED; PG8_LDA(At, 0, 0); PG8_STAGE(PG8_SA(1, 1), a1 + hstep, voffA);
            PG8_WAIT_L(8); PG8_BAR; PG8_WAIT_L(0); PG8_MMA(0, 0, At, B0); PG8_BAR; PG8_SCHED;
            PG8_LDB(B1, 0, 1); PG8_STAGE(PG8_SB(0, 0), b2, voffB);
            PG8_BAR; PG8_WAIT_L(0); PG8_MMA(0, 1, At, B1); PG8_BAR;
            PG8_LDA(At, 0, 1); PG8_STAGE(PG8_SA(0, 0), a2, voffA);
            PG8_BAR; PG8_WAIT_L(0); PG8_MMA(1, 0, At, B0); PG8_BAR; PG8_SCHED;
            PG8_STAGE(PG8_SB(0, 1), b2 + hstep, voffB);
            PG8_WAIT_V(6); PG8_BAR; PG8_MMA(1, 1, At, B1); PG8_BAR;
            PG8_LDB(B0, 1, 0); PG8_SCHED; PG8_LDA(At, 1, 0); PG8_STAGE(PG8_SA(0, 1), a2 + hstep, voffA);
            PG8_WAIT_L(8); PG8_BAR; PG8_WAIT_L(0); PG8_MMA(0, 0, At, B0); PG8_BAR; PG8_SCHED;
            PG8_LDB(B1, 1, 1); PG8_STAGE(PG8_SB(1, 0), b3, voffB);
            PG8_BAR; PG8_WAIT_L(0); PG8_MMA(0, 1, At, B1); PG8_BAR;
            PG8_LDA(At, 1, 1); PG8_STAGE(PG8_SA(1, 0), a3, voffA);
            PG8_BAR; PG8_WAIT_L(0); PG8_MMA(1, 0, At, B0); PG8_BAR; PG8_SCHED;
            PG8_STAGE(PG8_SB(1, 1), b3 + hstep, voffB);
            PG8_WAIT_V(6); PG8_BAR; PG8_MMA(1, 1, At, B1); PG8_BAR;
            }
        }
        if constexpr (ALIGN_EPI) { if (wr == 0) PG8_BAR; }
        if constexpr (!Epi::AFTER_DRAIN) { E(acc, cur, wr, wc, fr, fq); S.done(cur); }
        if (!has_next) break;
#pragma unroll
        for (int a = 0; a < 2; ++a)
#pragma unroll
            for (int b = 0; b < 2; ++b)
#pragma unroll
                for (int m = 0; m < 4; ++m)
#pragma unroll
                    for (int n = 0; n < 2; ++n) acc[a][b][m][n] = (f32x4){0.f, 0.f, 0.f, 0.f};
        cur = nxt; cA = nA; cB = nB; ++ui;
        if constexpr (ALIGN_EPI) { if (wr == 1) PG8_BAR; }
    }
    PG8_WAIT_V(0);
    if constexpr (!ALIGN_EPI) { if (wr == 0) PG8_BAR; }
    PG8_BAR;
    if constexpr (Epi::AFTER_DRAIN) { E.fused(acc, cur, wr, wc, fr, fq, lds, wid, lane); S.done(cur); }
#undef PG8_SA
#undef PG8_SB
#undef PG8_STAGE
#undef PG8_LDA
#undef PG8_LDB
#undef PG8_MMA
#undef PG8_WAIT_V
#undef PG8_WAIT_L
#undef PG8_BAR
#undef PG8_SCHED
}
}

#ifndef PG8_SP2
#define PG8_SP2 true
#endif
#ifndef PG8_ALIGN
#define PG8_ALIGN true
#endif
#define DI __device__ __forceinline__
#define LAS __attribute__((address_space(3)))
typedef LAS unsigned char* lds_t;
typedef unsigned short bf16_t;
typedef short bf16x8 __attribute__((ext_vector_type(8)));
typedef short s16x4 __attribute__((ext_vector_type(4)));
typedef short v4i16_t __attribute__((ext_vector_type(4)));
typedef float f32x4 __attribute__((ext_vector_type(4)));
typedef float f32x2 __attribute__((ext_vector_type(2)));
typedef unsigned u32x4 __attribute__((ext_vector_type(4)));
typedef unsigned u32x2 __attribute__((ext_vector_type(2)));

constexpr int T_ = 32768, L_ = 4096, D_ = 1024, IN_ = 10768, FF_ = 2816;
constexpr size_t MiB = 1u << 20;
constexpr size_t WS_WIN = 0, WS_WPA = 22 * MiB, WS_WPB = 24 * MiB, WS_WOUT = 25 * MiB, WS_WGU = 27 * MiB, WS_WDN = 38 * MiB;
constexpr size_t WS_ROPE = 44 * MiB, WS_BG = 45 * MiB, WS_LSE = 48 * MiB, WS_GL = 50 * MiB;
constexpr size_t U_ = 64 * MiB;
constexpr size_t S1 = 1 * U_, S2 = 2 * U_, S3 = 3 * U_, S4 = 4 * U_, S5 = 5 * U_, S6 = 6 * U_, S7 = 7 * U_;
constexpr size_t WS_AQKV = S1;
constexpr size_t WS_OG = S1 + 9 * U_ / 2;
constexpr size_t WS_DQKV = S1;
constexpr size_t WS_QD = S4, WS_KDT = S5, WS_U = S6, WS_W = S7;
constexpr size_t WS_ORAW = S1;
constexpr size_t WS_ZG = S4;
constexpr size_t WS_OA = S7;
constexpr size_t WS_PART = S1;
constexpr size_t WS_MERGED = S3;
constexpr size_t WS_X1 = S4;
constexpr size_t WS_H2 = S6;
constexpr size_t WS_ACT = S1;
constexpr size_t DO_H1 = 0, DO_OB = U_, DO_QK = U_ + U_ / 2;
constexpr int LDS_BYTES = 159744;

struct Params {
  const float *x, *norm1_w, *w_in, *conv_w, *a_log, *dt_bias, *dn_norm_w, *w_proj_a, *w_proj_b, *w_out, *norm2_w, *w_gate_up, *w_down, *final_norm_w;
  float* out; unsigned char* ws;
};

DI int lane_id() { int l; asm volatile("v_mbcnt_lo_u32_b32 %0, -1, 0\n\tv_mbcnt_hi_u32_b32 %0, -1, %0" : "=v"(l)); return l; }
#define TIDS() const int wave = wv, lane = lane_id(), tid = (wv << 6) | lane; (void)lane; (void)wave; (void)tid
typedef __bf16 bf16v2_t __attribute__((ext_vector_type(2)));
DI unsigned pk2(float lo, float hi) { const f32x2 v = {lo, hi}; return __builtin_bit_cast(unsigned, __builtin_convertvector(v, bf16v2_t)); }
DI unsigned f2bf(float f) { return pk2(f, 0.f) & 0xffffu; }
DI float bf2f(unsigned h) { return __builtin_bit_cast(float, h << 16); }
DI float bflo(unsigned w) { return __builtin_bit_cast(float, w << 16); }
DI float bfhi(unsigned w) { return __builtin_bit_cast(float, w & 0xffff0000u); }
#define BPERM(srcl, v) __shfl((v), (srcl))
template <int M> DI float shx(float v, int lane) { return BPERM(lane ^ M, v); }
DI float wave_sum(float v, int lane) { v += shx<1>(v, lane); v += shx<2>(v, lane); v += shx<4>(v, lane); v += shx<8>(v, lane); v += shx<16>(v, lane); v += shx<32>(v, lane); return v; }
DI float sum16(float v, int lane) { v += shx<1>(v, lane); v += shx<2>(v, lane); v += shx<4>(v, lane); v += shx<8>(v, lane); return v; }
DI float max16(float v, int lane) { v = fmaxf(v, shx<1>(v, lane)); v = fmaxf(v, shx<2>(v, lane)); v = fmaxf(v, shx<4>(v, lane)); v = fmaxf(v, shx<8>(v, lane)); return v; }
DI float sigmoidf_(float x) { return __builtin_amdgcn_rcpf(1.f + __expf(-x)); }
DI float siluf_(float x) { return x * __builtin_amdgcn_rcpf(1.f + __expf(-x)); }
DI s16x4 lds_tr(lds_t p) { return __builtin_bit_cast(s16x4, __builtin_amdgcn_ds_read_tr16_b64_v4i16((LAS v4i16_t*)p)); }
DI bf16x8 lds_ld16(lds_t p) { return *(LAS bf16x8*)p; }
#define MFMA16(a, b, c) __builtin_amdgcn_mfma_f32_16x16x32_bf16((a), (b), (c), 0, 0, 0)

using pg8::Unit;
DI unsigned cvt_pk_bf16(float lo, float hi) { return pk2(lo, hi); }
DI u32x4 pack8(f32x4 v0, f32x4 v1) { u32x4 w; w.x = cvt_pk_bf16(v0[0], v0[1]); w.y = cvt_pk_bf16(v0[2], v0[3]); w.z = cvt_pk_bf16(v1[0], v1[1]); w.w = cvt_pk_bf16(v1[2], v1[3]); return w; }

struct EpiRope {
  static constexpr bool PERM = true, AFTER_DRAIN = false;
  bf16_t* O; const float* rope;
  DI void operator()(const f32x4 (&acc)[2][2][4][2], const Unit& u, int wr, int wc, int fr, int fq) const {
    const int row0 = u.pm * 256 + wr * 64 + fr;
#pragma unroll
    for (int bj = 0; bj < 2; ++bj) {
      const int colb = u.pn * 256 + 128 * bj; const bool dorope = (colb < 3072) && (wc == 0);
#pragma unroll
      for (int ai = 0; ai < 2; ++ai)
#pragma unroll
        for (int m = 0; m < 4; ++m) {
          const int row = row0 + ai * 128 + m * 16; f32x4 v0 = acc[ai][bj][m][0], v1 = acc[ai][bj][m][1];
          if (dorope) {
            const int pos = row & (L_ - 1); const float* rp = rope + ((size_t)pos * 16 + 8 * (fq & 1)) * 2;
            f32x4 p0, p1;
#pragma unroll
            for (int e = 0; e < 4; ++e) { p0[e] = BPERM((fq * 16 + fr) ^ 32, v0[e]); p1[e] = BPERM((fq * 16 + fr) ^ 32, v1[e]); }
            const f32x4 c0 = *(const f32x4*)(rp), c1 = *(const f32x4*)(rp + 4), c2 = *(const f32x4*)(rp + 8), c3 = *(const f32x4*)(rp + 12);
            const float cs[8] = {c0[0], c0[2], c1[0], c1[2], c2[0], c2[2], c3[0], c3[2]}, sn[8] = {c0[1], c0[3], c1[1], c1[3], c2[1], c2[3], c3[1], c3[3]};
            const float sg = (fq < 2) ? -1.f : 1.f;
#pragma unroll
            for (int e = 0; e < 4; ++e) { v0[e] = v0[e] * cs[e] + sg * p0[e] * sn[e]; v1[e] = v1[e] * cs[4 + e] + sg * p1[e] * sn[4 + e]; }
          }
          *(u32x4*)(O + (size_t)row * 4608 + colb + wc * 32 + 8 * fq) = pack8(v0, v1);
        }
    }
  }
};
struct EpiDn {
  static constexpr bool PERM = true, AFTER_DRAIN = false;
  bf16_t* O; float* BG;
  DI void operator()(const f32x4 (&acc)[2][2][4][2], const Unit& u, int wr, int wc, int fr, int fq) const {
    const int row0 = u.pm * 256 + wr * 64 + fr;
    if (u.pn < 12) {
#pragma unroll
      for (int ai = 0; ai < 2; ++ai)
#pragma unroll
        for (int m = 0; m < 4; ++m)
#pragma unroll
          for (int bj = 0; bj < 2; ++bj)
            *(u32x4*)(O + (size_t)(row0 + ai * 128 + m * 16) * 3072 + u.pn * 256 + bj * 128 + wc * 32 + 8 * fq) = pack8(acc[ai][bj][m][0], acc[ai][bj][m][1]);
    } else if (wc == 0 && fq < 2) {
#pragma unroll
      for (int ai = 0; ai < 2; ++ai)
#pragma unroll
        for (int m = 0; m < 4; ++m) { float* o = BG + (size_t)(row0 + ai * 128 + m * 16) * 16 + 8 * fq; *(f32x4*)o = acc[ai][0][m][0]; *(f32x4*)(o + 4) = acc[ai][0][m][1]; }
    }
  }
};
struct EpiZG {
  static constexpr bool PERM = true, AFTER_DRAIN = false;
  bf16_t* O;
  DI void operator()(const f32x4 (&acc)[2][2][4][2], const Unit& u, int wr, int wc, int fr, int fq) const {
    const int row0 = u.pm * 256 + wr * 64 + fr; const bool sg = u.pn >= 4;
#pragma unroll
    for (int ai = 0; ai < 2; ++ai)
#pragma unroll
      for (int m = 0; m < 4; ++m)
#pragma unroll
        for (int bj = 0; bj < 2; ++bj) { f32x4 v0 = acc[ai][bj][m][0], v1 = acc[ai][bj][m][1];
          if (sg) {
#pragma unroll
            for (int e = 0; e < 4; ++e) { v0[e] = sigmoidf_(v0[e]); v1[e] = sigmoidf_(v1[e]); } }
          *(u32x4*)(O + (size_t)(row0 + ai * 128 + m * 16) * 3072 + u.pn * 256 + bj * 128 + wc * 32 + 8 * fq) = pack8(v0, v1); }
  }
};
struct EpiYa {
  static constexpr bool PERM = true, AFTER_DRAIN = false;
  bf16_t* PART; const bf16_t* ZG;
  DI void operator()(const f32x4 (&acc)[2][2][4][2], const Unit& u, int wr, int wc, int fr, int fq) const {
    const int row0 = u.pm * 256 + wr * 64 + fr;
#pragma unroll
    for (int ai = 0; ai < 2; ++ai)
#pragma unroll
      for (int m = 0; m < 4; ++m)
#pragma unroll
        for (int bj = 0; bj < 2; ++bj) { const int row = row0 + ai * 128 + m * 16, col = u.pn * 256 + bj * 128 + wc * 32 + 8 * fq;
          const u32x4 g = *(const u32x4*)(ZG + (size_t)row * 3072 + 1024 + col);
          f32x4 v0 = acc[ai][bj][m][0], v1 = acc[ai][bj][m][1];
          v0[0] *= bflo(g.x); v0[1] *= bfhi(g.x); v0[2] *= bflo(g.y); v0[3] *= bfhi(g.y); v1[0] *= bflo(g.z); v1[1] *= bfhi(g.z); v1[2] *= bflo(g.w); v1[3] *= bfhi(g.w);
          *(u32x4*)(PART + (size_t)row * 1024 + col) = pack8(v0, v1); }
  }
};
struct EpiYb {
  static constexpr bool PERM = true, AFTER_DRAIN = false;
  const bf16_t* PART; const bf16_t* ZG; bf16_t* MG;
  DI void operator()(const f32x4 (&acc)[2][2][4][2], const Unit& u, int wr, int wc, int fr, int fq) const {
    const int row0 = u.pm * 256 + wr * 64 + fr;
#pragma unroll
    for (int ai = 0; ai < 2; ++ai)
#pragma unroll
      for (int m = 0; m < 4; ++m)
#pragma unroll
        for (int bj = 0; bj < 2; ++bj) { const int row = row0 + ai * 128 + m * 16, col = u.pn * 256 + bj * 128 + wc * 32 + 8 * fq;
          const u32x4 g = *(const u32x4*)(ZG + (size_t)row * 3072 + 2048 + col);
          const u32x4 pq = *(const u32x4*)(PART + (size_t)row * 1024 + col); f32x4 v0 = {bflo(pq.x), bfhi(pq.x), bflo(pq.y), bfhi(pq.y)}, v1 = {bflo(pq.z), bfhi(pq.z), bflo(pq.w), bfhi(pq.w)};
          const f32x4 a0 = acc[ai][bj][m][0], a1 = acc[ai][bj][m][1];
          v0[0] += a0[0] * bflo(g.x); v0[1] += a0[1] * bfhi(g.x); v0[2] += a0[2] * bflo(g.y); v0[3] += a0[3] * bfhi(g.y);
          v1[0] += a1[0] * bflo(g.z); v1[1] += a1[1] * bfhi(g.z); v1[2] += a1[2] * bflo(g.w); v1[3] += a1[3] * bfhi(g.w);
          *(u32x4*)(MG + (size_t)row * 1024 + col) = pack8(v0, v1); }
  }
};
struct EpiRes {
  static constexpr bool PERM = true, AFTER_DRAIN = false;
  const float* RES; float* OUT;
  DI void operator()(const f32x4 (&acc)[2][2][4][2], const Unit& u, int wr, int wc, int fr, int fq) const {
    const int row0 = u.pm * 256 + wr * 64 + fr;
#pragma unroll
    for (int ai = 0; ai < 2; ++ai)
#pragma unroll
      for (int m = 0; m < 4; ++m)
#pragma unroll
        for (int bj = 0; bj < 2; ++bj) { const size_t off = (size_t)(row0 + ai * 128 + m * 16) * 1024 + u.pn * 256 + bj * 128 + wc * 32 + 8 * fq;
          const f32x4 r0 = *(const f32x4*)(RES + off), r1 = *(const f32x4*)(RES + off + 4);
          *(f32x4*)(OUT + off) = r0 + acc[ai][bj][m][0]; *(f32x4*)(OUT + off + 4) = r1 + acc[ai][bj][m][1]; }
  }
};
struct EpiResToB {
  static constexpr bool PERM = true, AFTER_DRAIN = false;
  const float* RES; bf16_t* OUT;
  DI void operator()(const f32x4 (&acc)[2][2][4][2], const Unit& u, int wr, int wc, int fr, int fq) const {
    const int row0 = u.pm * 256 + wr * 64 + fr;
#pragma unroll
    for (int ai = 0; ai < 2; ++ai)
#pragma unroll
      for (int m = 0; m < 4; ++m)
#pragma unroll
        for (int bj = 0; bj < 2; ++bj) { const size_t off = (size_t)(row0 + ai * 128 + m * 16) * 1024 + u.pn * 256 + bj * 128 + wc * 32 + 8 * fq;
          const f32x4 r0 = *(const f32x4*)(RES + off), r1 = *(const f32x4*)(RES + off + 4);
          *(u32x4*)(OUT + off) = pack8(r0 + acc[ai][bj][m][0], r1 + acc[ai][bj][m][1]); }
  }
};
struct EpiResFromB {
  static constexpr bool PERM = true, AFTER_DRAIN = false;
  const bf16_t* RES; float* OUT;
  DI void operator()(const f32x4 (&acc)[2][2][4][2], const Unit& u, int wr, int wc, int fr, int fq) const {
    const int row0 = u.pm * 256 + wr * 64 + fr;
#pragma unroll
    for (int ai = 0; ai < 2; ++ai)
#pragma unroll
      for (int m = 0; m < 4; ++m)
#pragma unroll
        for (int bj = 0; bj < 2; ++bj) { const size_t off = (size_t)(row0 + ai * 128 + m * 16) * 1024 + u.pn * 256 + bj * 128 + wc * 32 + 8 * fq;
          const u32x4 q = *(const u32x4*)(RES + off);
          const f32x4 r0 = {bflo(q.x), bfhi(q.x), bflo(q.y), bfhi(q.y)}, r1 = {bflo(q.z), bfhi(q.z), bflo(q.w), bfhi(q.w)};
          *(f32x4*)(OUT + off) = r0 + acc[ai][bj][m][0]; *(f32x4*)(OUT + off + 4) = r1 + acc[ai][bj][m][1]; }
  }
};
struct EpiResBB {
  static constexpr bool PERM = true, AFTER_DRAIN = false;
  const bf16_t* RES; bf16_t* OUT;
  DI void operator()(const f32x4 (&acc)[2][2][4][2], const Unit& u, int wr, int wc, int fr, int fq) const {
    const int row0 = u.pm * 256 + wr * 64 + fr;
#pragma unroll
    for (int ai = 0; ai < 2; ++ai)
#pragma unroll
      for (int m = 0; m < 4; ++m)
#pragma unroll
        for (int bj = 0; bj < 2; ++bj) { const size_t off = (size_t)(row0 + ai * 128 + m * 16) * 1024 + u.pn * 256 + bj * 128 + wc * 32 + 8 * fq;
          const u32x4 q = *(const u32x4*)(RES + off);
          const f32x4 r0 = {bflo(q.x), bfhi(q.x), bflo(q.y), bfhi(q.y)}, r1 = {bflo(q.z), bfhi(q.z), bflo(q.w), bfhi(q.w)};
          *(u32x4*)(OUT + off) = pack8(r0 + acc[ai][bj][m][0], r1 + acc[ai][bj][m][1]); }
  }
};
struct EpiSwiglu {
  static constexpr bool PERM = true, AFTER_DRAIN = false;
  bf16_t* ACT;
  DI void operator()(const f32x4 (&acc)[2][2][4][2], const Unit& u, int wr, int wc, int fr, int fq) const {
    const int row0 = u.pm * 256 + wr * 64 + fr;
#pragma unroll
    for (int ai = 0; ai < 2; ++ai)
#pragma unroll
      for (int m = 0; m < 4; ++m) { f32x4 v0, v1;
#pragma unroll
        for (int e = 0; e < 4; ++e) { v0[e] = siluf_(acc[ai][0][m][0][e]) * acc[ai][1][m][0][e]; v1[e] = siluf_(acc[ai][0][m][1][e]) * acc[ai][1][m][1][e]; }
        *(u32x4*)(ACT + (size_t)(row0 + ai * 128 + m * 16) * FF_ + u.pn * 128 + wc * 32 + 8 * fq) = pack8(v0, v1); }
  }
};
DI void tr_item(const float* W, int ldw, int K, bf16_t* WT, LAS float* scr, int k0, int lane) {
  float tv[32];
#pragma unroll
  for (int i = 0; i < 32; ++i) tv[i] = W[(size_t)(k0 + 2 * i + (lane >> 5)) * ldw + (lane & 31)];
#pragma unroll
  for (int i = 0; i < 32; ++i) scr[(2 * i + (lane >> 5)) * 33 + (lane & 31)] = tv[i];
  asm volatile("s_waitcnt lgkmcnt(0)" ::: "memory");
  const int c = lane & 7;
#pragma unroll
  for (int j = 0; j < 4; ++j) { const int n = (lane >> 3) + 8 * j; const LAS float* s = scr + (8 * c) * 33 + n;
    u32x4 o; o.x = pk2(s[0 * 33], s[1 * 33]); o.y = pk2(s[2 * 33], s[3 * 33]); o.z = pk2(s[4 * 33], s[5 * 33]); o.w = pk2(s[6 * 33], s[7 * 33]);
    *(u32x4*)(WT + (size_t)n * K + k0 + 8 * c) = o; }
  asm volatile("s_waitcnt lgkmcnt(0)" ::: "memory");
}
DI void rms_row_bf16(const float* xrow, const float* w, bf16_t* orow, int lane) {
  const f32x4* xr = (const f32x4*)xrow + lane; const f32x4* wr = (const f32x4*)w + lane;
  f32x4 v[4]; float s = 0.f;
#pragma unroll
  for (int j = 0; j < 4; ++j) { v[j] = xr[64 * j]; s += (v[j].x * v[j].x + v[j].y * v[j].y) + (v[j].z * v[j].z + v[j].w * v[j].w); }
  const float r = 1.f / sqrtf(wave_sum(s, lane) * (1.f / 1024.f) + 1e-6f);
  unsigned long long* o8 = (unsigned long long*)orow + lane;
#pragma unroll
  for (int j = 0; j < 4; ++j) { const f32x4 g = wr[64 * j];
    o8[64 * j] = (unsigned long long)pk2(v[j].x * r * g.x, v[j].y * r * g.y) | ((unsigned long long)pk2(v[j].z * r * g.z, v[j].w * r * g.w) << 32); }
}
DI void rms_row2_bf16(const float* x0, const float* x1, const float* w, bf16_t* o0, bf16_t* o1, int lane) {
  const f32x4* xa = (const f32x4*)x0 + lane; const f32x4* xb = (const f32x4*)x1 + lane; const f32x4* wr = (const f32x4*)w + lane;
  f32x4 va[4], vb[4]; float sa = 0.f, sb = 0.f;
#pragma unroll
  for (int j = 0; j < 4; ++j) { va[j] = xa[64 * j]; vb[j] = xb[64 * j]; }
#pragma unroll
  for (int j = 0; j < 4; ++j) { sa += (va[j].x * va[j].x + va[j].y * va[j].y) + (va[j].z * va[j].z + va[j].w * va[j].w); sb += (vb[j].x * vb[j].x + vb[j].y * vb[j].y) + (vb[j].z * vb[j].z + vb[j].w * vb[j].w); }
  const float ra = 1.f / sqrtf(wave_sum(sa, lane) * (1.f / 1024.f) + 1e-6f), rb = 1.f / sqrtf(wave_sum(sb, lane) * (1.f / 1024.f) + 1e-6f);
  unsigned long long* pa = (unsigned long long*)o0 + lane; unsigned long long* pb = (unsigned long long*)o1 + lane;
#pragma unroll
  for (int j = 0; j < 4; ++j) { const f32x4 g = wr[64 * j];
    pa[64 * j] = (unsigned long long)pk2(va[j].x * ra * g.x, va[j].y * ra * g.y) | ((unsigned long long)pk2(va[j].z * ra * g.z, va[j].w * ra * g.w) << 32);
    pb[64 * j] = (unsigned long long)pk2(vb[j].x * rb * g.x, vb[j].y * rb * g.y) | ((unsigned long long)pk2(vb[j].z * rb * g.z, vb[j].w * rb * g.w) << 32); }
}
DI void p0_prologue(const Params& p, lds_t lds, int wv) { TIDS();
  unsigned char* ws = p.ws;
  LAS float* scr = (LAS float*)(lds + wave * 16384);
  const int gw = blockIdx.x * 8 + wave, NGW = gridDim.x * 8;
  bf16_t* WIN = (bf16_t*)(ws + WS_WIN);
  constexpr int I0 = 16 * 144, I1 = 16 * 96, I2 = 16, I3 = 16 * 32, I4 = 16 * 64, I5 = 16 * 32, I6 = 8 * 32, I7 = 16 * 32, I8 = 16 * 176, I9 = 44 * 32;
  constexpr int NITEMS = I0 + I1 + I2 + I3 + I4 + I5 + I6 + I7 + I8 + I9;
  for (int it = gw; it < NITEMS; it += NGW) {
    int r = it;
    if (r < I0) { const int kb = r / 144, nb = r % 144; tr_item(p.w_in + 4112 + 32 * nb, IN_, 1024, WIN + (size_t)(0 + 32 * nb) * 1024, scr, 64 * kb, lane); continue; } r -= I0;
    if (r < I1) { const int kb = r / 96, nb = r % 96; tr_item(p.w_in + 0 + 32 * nb, IN_, 1024, WIN + (size_t)(4608 + 32 * nb) * 1024, scr, 64 * kb, lane); continue; } r -= I1;
    if (r < I2) { const int kb = r; tr_item(p.w_in + 4096, IN_, 1024, WIN + (size_t)7680 * 1024, scr, 64 * kb, lane); continue; } r -= I2;
    if (r < I3) { const int kb = r / 32, nb = r % 32; tr_item(p.w_in + 3072 + 32 * nb, IN_, 1024, WIN + (size_t)(7936 + 32 * nb) * 1024, scr, 64 * kb, lane); continue; } r -= I3;
    if (r < I4) { const int kb = r / 64, nb = r % 64; tr_item(p.w_in + 8720 + 32 * nb, IN_, 1024, WIN + (size_t)(8960 + 32 * nb) * 1024, scr, 64 * kb, lane); continue; } r -= I4;
    if (r < I5) { const int kb = r / 32, nb = r % 32; tr_item(p.w_proj_a + 32 * nb, 1024, 1024, (bf16_t*)(ws + WS_WPA) + (size_t)(32 * nb) * 1024, scr, 64 * kb, lane); continue; } r -= I5;
    if (r < I6) { const int kb = r / 32, nb = r % 32; tr_item(p.w_proj_b + 32 * nb, 1024, 512, (bf16_t*)(ws + WS_WPB) + (size_t)(32 * nb) * 512, scr, 64 * kb, lane); continue; } r -= I6;
    if (r < I7) { const int kb = r / 32, nb = r % 32; tr_item(p.w_out + 32 * nb, 1024, 1024, (bf16_t*)(ws + WS_WOUT) + (size_t)(32 * nb) * 1024, scr, 64 * kb, lane); continue; } r -= I7;
    if (r < I8) { const int kb = r / 176, nb = r % 176; const int pn = nb >> 3, bj = (nb >> 2) & 1, r0 = (nb & 3) * 32;
      tr_item(p.w_gate_up + bj * FF_ + 128 * pn + r0, 2 * FF_, 1024, (bf16_t*)(ws + WS_WGU) + (size_t)(32 * nb) * 1024, scr, 64 * kb, lane); continue; } r -= I8;
    { const int kb = r / 32, nb = r % 32; tr_item(p.w_down + 32 * nb, 1024, FF_, (bf16_t*)(ws + WS_WDN) + (size_t)(32 * nb) * FF_, scr, 64 * kb, lane); }
  }
  { float* rope = (float*)(ws + WS_ROPE);
    for (int i = blockIdx.x * 512 + tid; i < L_ * 16; i += gridDim.x * 512) { const int pos = i >> 4, f = i & 15;
      const float invf = powf(500000.0f, -(float)f * (1.0f / 16.0f)); const float ang = (float)pos * invf; float sn, cs; sincosf(ang, &sn, &cs);
      rope[2 * i] = cs; rope[2 * i + 1] = sn; } }
  bf16_t* H1 = (bf16_t*)((unsigned char*)p.out + DO_H1);
  for (int m = gw; m < T_; m += 2 * NGW) { const int m2 = (m + NGW < T_) ? m + NGW : m; rms_row2_bf16(p.x + (size_t)m * D_, p.x + (size_t)m2 * D_, p.norm1_w, H1 + (size_t)m * D_, H1 + (size_t)m2 * D_, lane); }
}

constexpr int AT_RS = 272;
constexpr int AT_VS = 288;
constexpr int AT_KV_BYTES = 272 * AT_VS;
constexpr int AT_PS = 336;
constexpr int AT_P_OFF = AT_KV_BYTES, AT_P_WAVE = 16 * AT_PS;
DI void attn_unit_coords(int unit, int& g, int& dsh, int& hs, int& b, int& r, int& nb, int& head) {
  g = unit >> 10; const int rem = unit & 1023; dsh = 2 * g; const int nbk = 32 >> dsh;
  hs = rem & 3; const int rest = rem >> 2; b = rest >> 5; const int within = rest & 31; r = within / nbk; nb = within % nbk; head = g * 4 + hs;
}
DI void attn_load(u32x4 (&v)[8], const bf16_t* base  , int b, int r, int nb, int dsh, int tid) {
#pragma unroll
  for (int pss = 0; pss < 8; ++pss) { const int idx = tid + 512 * pss, key = idx >> 4, ch = idx & 15;
    const int mi = (nb - 1) * 128 + key; v[pss] = (u32x4){0u, 0u, 0u, 0u};
    if (mi >= 0) { const size_t row = (size_t)b * L_ + ((size_t)mi << dsh) + r; v[pss] = *(const u32x4*)(base + row * 4608 + ch * 8); } }
}
template <int PITCH> DI void attn_store(lds_t buf, const u32x4 (&v)[8], int tid) {
#pragma unroll
  for (int pss = 0; pss < 8; ++pss) { const int idx = tid + 512 * pss, key = idx >> 4, ch = idx & 15; *(LAS u32x4*)(buf + key * PITCH + ch * 16) = v[pss]; }
  if (tid < 256) { const int key = 256 + (tid >> 4), ch = tid & 15; *(LAS u32x4*)(buf + key * PITCH + ch * 16) = (u32x4){0u, 0u, 0u, 0u}; }
}
#define LDS_BAR() do { asm volatile("s_waitcnt lgkmcnt(0)" ::: "memory"); __builtin_amdgcn_s_barrier(); asm volatile("" ::: "memory"); } while (0)
DI void attn_phase(const Params& p, lds_t lds, int wv) { TIDS();
  const bf16_t* AQKV = (const bf16_t*)(p.ws + WS_AQKV); bf16_t* OG = (bf16_t*)(p.ws + WS_OG); float* LSE = (float*)(p.ws + WS_LSE);
  const int fr = lane & 15, fq = lane >> 4;
  lds_t Pw = lds + AT_P_OFF + wave * AT_P_WAVE;
  u32x4 kreg[8], vreg[8]; bf16x8 qf[4];
  int g, dsh, hs, b, r, nb, head;
  if ((int)blockIdx.x < 3072) {
    attn_unit_coords(blockIdx.x, g, dsh, hs, b, r, nb, head);
    attn_load(kreg, AQKV + 1536 + head * 128, b, r, nb, dsh, tid);
    const size_t qrow = (size_t)b * L_ + (((size_t)(nb * 128 + 16 * wave + fr)) << dsh) + r; const bf16_t* qp = AQKV + qrow * 4608 + head * 128 + fq * 8;
#pragma unroll
    for (int ks = 0; ks < 4; ++ks) qf[ks] = *(const bf16x8*)(qp + ks * 32);
  }
  for (int unit = blockIdx.x; unit < 3072; unit += gridDim.x) {
    attn_unit_coords(unit, g, dsh, hs, b, r, nb, head);
    LDS_BAR();
    attn_store<AT_RS>(lds, kreg, tid);
    attn_load(vreg, AQKV + 3072 + head * 128, b, r, nb, dsh, tid);
    bf16x8 qc[4];
#pragma unroll
    for (int ks = 0; ks < 4; ++ks) qc[ks] = qf[ks];
    LDS_BAR();
    f32x4 sc[9];
#pragma unroll
    for (int ct = 0; ct < 9; ++ct) { sc[ct] = (f32x4){0.f, 0.f, 0.f, 0.f};
      lds_t kp = lds + (16 * (wave + ct) + fr) * AT_RS + fq * 16;
#pragma unroll
      for (int ks = 0; ks < 4; ++ks) sc[ct] = MFMA16(qc[ks], lds_ld16(kp + ks * 64), sc[ct]); }
    const float SCL = 0.08838834764831845f * 1.4426950408889634f;
    float mx[4] = {-3.0e38f, -3.0e38f, -3.0e38f, -3.0e38f};
#pragma unroll
    for (int ct = 0; ct < 9; ++ct) { const bool tile_ok = (nb > 0) || (wave + ct >= 8);
#pragma unroll
      for (int j = 0; j < 4; ++j) { bool ok = tile_ok;
        if (ct == 0) ok = ok && (fr >= 4 * fq + j);
        if (ct == 8) ok = ok && (fr <= 4 * fq + j);
        const float s = ok ? sc[ct][j] : -3.0e38f; sc[ct][j] = s; mx[j] = fmaxf(mx[j], s); } }
#pragma unroll
    for (int j = 0; j < 4; ++j) mx[j] = max16(mx[j], lane) * SCL;
    float den[4] = {0.f, 0.f, 0.f, 0.f};
#pragma unroll
    for (int ct = 0; ct < 9; ++ct)
#pragma unroll
      for (int j = 0; j < 4; ++j) { const float e = __builtin_amdgcn_exp2f(fmaf(sc[ct][j], SCL, -mx[j])); den[j] += e;
        *(LAS bf16_t*)(Pw + (4 * fq + j) * AT_PS + (16 * ct + fr) * 2) = (bf16_t)f2bf(e); }
#pragma unroll
    for (int j = 0; j < 4; ++j) { *(LAS bf16_t*)(Pw + (4 * fq + j) * AT_PS + (144 + fr) * 2) = 0; den[j] = sum16(den[j], lane); }
    LDS_BAR();
    attn_store<AT_VS>(lds, vreg, tid);
    { const int nu = unit + gridDim.x;
      if (nu < 3072) { int g2, dsh2, hs2, b2, r2, nb2, head2; attn_unit_coords(nu, g2, dsh2, hs2, b2, r2, nb2, head2);
        attn_load(kreg, AQKV + 1536 + head2 * 128, b2, r2, nb2, dsh2, tid);
        const size_t qrow = (size_t)b2 * L_ + (((size_t)(nb2 * 128 + 16 * wave + fr)) << dsh2) + r2; const bf16_t* qp = AQKV + qrow * 4608 + head2 * 128 + fq * 8;
#pragma unroll
        for (int ks = 0; ks < 4; ++ks) qf[ks] = *(const bf16x8*)(qp + ks * 32); } }
    LDS_BAR();
    f32x4 oa[8];
#pragma unroll
    for (int dt = 0; dt < 8; ++dt) oa[dt] = (f32x4){0.f, 0.f, 0.f, 0.f};
#pragma unroll
    for (int ks = 0; ks < 5; ++ks) { const bf16x8 a = lds_ld16(Pw + fr * AT_PS + (ks * 32 + fq * 8) * 2);
      lds_t vp = lds + (16 * wave + ks * 32 + fq * 8 + (fr >> 2)) * AT_VS + (fr & 3) * 8;
#pragma unroll
      for (int dt = 0; dt < 8; ++dt) { const s16x4 lo = lds_tr(vp + dt * 32), hi = lds_tr(vp + 4 * AT_VS + dt * 32);
        const bf16x8 bb = __builtin_shufflevector(lo, hi, 0, 1, 2, 3, 4, 5, 6, 7); oa[dt] = MFMA16(a, bb, oa[dt]); } }
#pragma unroll
    for (int j = 0; j < 4; ++j) { const int qi = 16 * wave + 4 * fq + j; const size_t row = (size_t)b * L_ + (((size_t)(nb * 128 + qi)) << dsh) + r;
      const float inv = 1.f / den[j]; bf16_t* op = OG + ((size_t)g * T_ + row) * 512 + hs * 128 + fr;
#pragma unroll
      for (int dt = 0; dt < 8; ++dt) op[dt * 16] = (bf16_t)f2bf(oa[dt][j] * inv);
      if (fr == 0) LSE[((size_t)g * T_ + row) * 4 + hs] = (mx[j] + log2f(den[j])) * 0.6931471805599453f; }
  }
}
DI void combine_phase(const Params& p, int wv) { TIDS();
  const bf16_t* OG = (const bf16_t*)(p.ws + WS_OG); const float* LSE = (const float*)(p.ws + WS_LSE); bf16_t* OB = (bf16_t*)((unsigned char*)p.out + DO_OB);
  for (size_t it = (size_t)blockIdx.x * 512 + tid; it < (size_t)T_ * 64; it += (size_t)gridDim.x * 512) {
    const size_t row = it >> 6; const int c = (int)(it & 63), hs = c >> 4;
    const float l0 = LSE[row * 4 + hs], l1 = LSE[((size_t)T_ + row) * 4 + hs], l2 = LSE[((size_t)2 * T_ + row) * 4 + hs];
    const float mx = fmaxf(l0, fmaxf(l1, l2)); float e0 = __expf(l0 - mx), e1 = __expf(l1 - mx), e2 = __expf(l2 - mx); const float inv = 1.f / (e0 + e1 + e2); e0 *= inv; e1 *= inv; e2 *= inv;
    const u32x4 a = *(const u32x4*)(OG + row * 512 + c * 8), bq = *(const u32x4*)(OG + ((size_t)T_ + row) * 512 + c * 8), cq = *(const u32x4*)(OG + ((size_t)2 * T_ + row) * 512 + c * 8);
    u32x4 o;
    o.x = pk2(e0 * bflo(a.x) + e1 * bflo(bq.x) + e2 * bflo(cq.x), e0 * bfhi(a.x) + e1 * bfhi(bq.x) + e2 * bfhi(cq.x));
    o.y = pk2(e0 * bflo(a.y) + e1 * bflo(bq.y) + e2 * bflo(cq.y), e0 * bfhi(a.y) + e1 * bfhi(bq.y) + e2 * bfhi(cq.y));
    o.z = pk2(e0 * bflo(a.z) + e1 * bflo(bq.z) + e2 * bflo(cq.z), e0 * bfhi(a.z) + e1 * bfhi(bq.z) + e2 * bfhi(cq.z));
    o.w = pk2(e0 * bflo(a.w) + e1 * bflo(bq.w) + e2 * bflo(cq.w), e0 * bfhi(a.w) + e1 * bfhi(bq.w) + e2 * bfhi(cq.w));
    *(u32x4*)(OB + row * 512 + c * 8) = o;
  }
}

DI void bg_phase(const Params& p, int wv) { TIDS();
  const bf16_t* H1 = (const bf16_t*)((const unsigned char*)p.out + DO_H1); const bf16_t* WB = (const bf16_t*)(p.ws + WS_WIN) + (size_t)7680 * 1024; float* BG = (float*)(p.ws + WS_BG);
  const int fr = lane & 15, fq = lane >> 4;
  for (int tile = blockIdx.x * 8 + wave; tile < T_ / 16; tile += gridDim.x * 8) {
    const bf16_t* ap = H1 + ((size_t)tile * 16 + fr) * 1024 + fq * 8; const bf16_t* bp = WB + (size_t)fr * 1024 + fq * 8;
    f32x4 acc0 = {0.f, 0.f, 0.f, 0.f}, acc1 = {0.f, 0.f, 0.f, 0.f};
#pragma unroll 8
    for (int ks = 0; ks < 32; ks += 2) { acc0 = MFMA16(*(const bf16x8*)(ap + ks * 32), *(const bf16x8*)(bp + ks * 32), acc0); acc1 = MFMA16(*(const bf16x8*)(ap + ks * 32 + 32), *(const bf16x8*)(bp + ks * 32 + 32), acc1); }
#pragma unroll
    for (int j = 0; j < 4; ++j) BG[((size_t)tile * 16 + 4 * fq + j) * 16 + fr] = acc0[j] + acc1[j];
  }
}
template <int NL> DI void lds_row_read(f32x4 (&a)[16], unsigned addr);
template <> DI void lds_row_read<16>(f32x4 (&a)[16], unsigned addr) {
  asm volatile("ds_read_b128 %0, %16\n\tds_read_b128 %1, %16 offset:16\n\tds_read_b128 %2, %16 offset:32\n\tds_read_b128 %3, %16 offset:48\n\t"
               "ds_read_b128 %4, %16 offset:64\n\tds_read_b128 %5, %16 offset:80\n\tds_read_b128 %6, %16 offset:96\n\tds_read_b128 %7, %16 offset:112\n\t"
               "ds_read_b128 %8, %16 offset:128\n\tds_read_b128 %9, %16 offset:144\n\tds_read_b128 %10, %16 offset:160\n\tds_read_b128 %11, %16 offset:176\n\t"
               "ds_read_b128 %12, %16 offset:192\n\tds_read_b128 %13, %16 offset:208\n\tds_read_b128 %14, %16 offset:224\n\tds_read_b128 %15, %16 offset:240\n\ts_waitcnt lgkmcnt(0)"
               : "=&v"(a[0]), "=&v"(a[1]), "=&v"(a[2]), "=&v"(a[3]), "=&v"(a[4]), "=&v"(a[5]), "=&v"(a[6]), "=&v"(a[7]), "=&v"(a[8]), "=&v"(a[9]), "=&v"(a[10]), "=&v"(a[11]), "=&v"(a[12]), "=&v"(a[13]), "=&v"(a[14]), "=&v"(a[15])
               : "v"(addr) : "memory");
}
template <> DI void lds_row_read<12>(f32x4 (&a)[16], unsigned addr) {
  asm volatile("ds_read_b128 %0, %12\n\tds_read_b128 %1, %12 offset:16\n\tds_read_b128 %2, %12 offset:32\n\tds_read_b128 %3, %12 offset:48\n\t"
               "ds_read_b128 %4, %12 offset:64\n\tds_read_b128 %5, %12 offset:80\n\tds_read_b128 %6, %12 offset:96\n\tds_read_b128 %7, %12 offset:112\n\t"
               "ds_read_b128 %8, %12 offset:128\n\tds_read_b128 %9, %12 offset:144\n\tds_read_b128 %10, %12 offset:160\n\tds_read_b128 %11, %12 offset:176\n\ts_waitcnt lgkmcnt(0)"
               : "=&v"(a[0]), "=&v"(a[1]), "=&v"(a[2]), "=&v"(a[3]), "=&v"(a[4]), "=&v"(a[5]), "=&v"(a[6]), "=&v"(a[7]), "=&v"(a[8]), "=&v"(a[9]), "=&v"(a[10]), "=&v"(a[11])
               : "v"(addr) : "memory");
}
template <> DI void lds_row_read<8>(f32x4 (&a)[16], unsigned addr) {
  asm volatile("ds_read_b128 %0, %8\n\tds_read_b128 %1, %8 offset:16\n\tds_read_b128 %2, %8 offset:32\n\tds_read_b128 %3, %8 offset:48\n\t"
               "ds_read_b128 %4, %8 offset:64\n\tds_read_b128 %5, %8 offset:80\n\tds_read_b128 %6, %8 offset:96\n\tds_read_b128 %7, %8 offset:112\n\ts_waitcnt lgkmcnt(0)"
               : "=&v"(a[0]), "=&v"(a[1]), "=&v"(a[2]), "=&v"(a[3]), "=&v"(a[4]), "=&v"(a[5]), "=&v"(a[6]), "=&v"(a[7])
               : "v"(addr) : "memory");
}
template <> DI void lds_row_read<4>(f32x4 (&a)[16], unsigned addr) {
  asm volatile("ds_read_b128 %0, %4\n\tds_read_b128 %1, %4 offset:16\n\tds_read_b128 %2, %4 offset:32\n\tds_read_b128 %3, %4 offset:48\n\ts_waitcnt lgkmcnt(0)"
               : "=&v"(a[0]), "=&v"(a[1]), "=&v"(a[2]), "=&v"(a[3]) : "v"(addr) : "memory");
}
template <int J> DI void subst_rows(float (&t)[64], unsigned abase) {
  if constexpr (J < 63) {
    constexpr int I40 = (J + 1) / 4, G0 = I40 / 4;
    const float xj = t[J];
    if constexpr (G0 < 2) {
      f32x4 a[16]; lds_row_read<8 - 4 * G0>(a, abase + (unsigned)((J * 68 + 16 * G0) * 4));
#pragma unroll
      for (int i4 = (I40 > 4 * G0 ? I40 : 4 * G0); i4 < 8; ++i4) { const f32x4 v = a[i4 - 4 * G0];
        t[4 * i4] -= v[0] * xj; t[4 * i4 + 1] -= v[1] * xj; t[4 * i4 + 2] -= v[2] * xj; t[4 * i4 + 3] -= v[3] * xj; }
    }
    { constexpr int G1 = G0 < 2 ? 2 : G0;
      f32x4 a[16]; lds_row_read<16 - 4 * G1>(a, abase + (unsigned)((J * 68 + 16 * G1) * 4));
#pragma unroll
      for (int i4 = (I40 > 4 * G1 ? I40 : 4 * G1); i4 < 16; ++i4) { const f32x4 v = a[i4 - 4 * G1];
        t[4 * i4] -= v[0] * xj; t[4 * i4 + 1] -= v[1] * xj; t[4 * i4 + 2] -= v[2] * xj; t[4 * i4 + 3] -= v[3] * xj; }
    }
    subst_rows<J + 1>(t, abase);
  }
}
constexpr int CP_RS = 272;
constexpr int CP_K = 0, CP_Q = 17408, CP_VB = 34816, CP_KG = 52224, CP_AF = 69632  , CP_TB = 87040  , CP_GC = 96256, CP_BETA = 96512;
DI void chunkprep_phase(const Params& p, lds_t lds, int wv) { TIDS(); float* QS1 = (float*)(p.ws + 52 * MiB);
  unsigned char* ws = p.ws;
  const bf16_t* DQKV = (const bf16_t*)(ws + WS_DQKV); const float* BG = (const float*)(ws + WS_BG);
  bf16_t* QD = (bf16_t*)(ws + WS_QD); bf16_t* KDT = (bf16_t*)(ws + WS_KDT); bf16_t* Ug = (bf16_t*)(ws + WS_U); bf16_t* Wg = (bf16_t*)(ws + WS_W);
  bf16_t* QK = (bf16_t*)((unsigned char*)p.out + DO_QK); float* GL = (float*)(ws + WS_GL);
  LAS float* gcs = (LAS float*)(lds + CP_GC); LAS float* betas = (LAS float*)(lds + CP_BETA); LAS float* Af = (LAS float*)(lds + CP_AF);
  const int fr = lane & 15, fq = lane >> 4;
  for (int unit = blockIdx.x; unit < 4096; unit += gridDim.x) {
    const int bh = unit >> 6, n = unit & 63, b = bh >> 3, h = bh & 7;
    const size_t row0 = (size_t)b * L_ + n * 64;
    __syncthreads();
    if (wave == 0) {
      const float db = BG[(row0 + lane) * 16 + h], da = BG[(row0 + lane) * 16 + 8 + h];
      const float xx = da + p.dt_bias[h]; const float sp = (xx > 20.f) ? xx : log1pf(__expf(xx));
      float gg = -__expf(p.a_log[h]) * sp;
#pragma unroll
      for (int o = 1; o < 64; o <<= 1) { const float t = BPERM((lane - o) & 63, gg); if (lane >= o) gg += t; }
      gcs[lane] = gg; betas[lane] = sigmoidf_(db);
      if (lane == 63) GL[unit] = __expf(gg);
      QS1[(size_t)bh * L_ + n * 64 + lane] = 1.f;
    }
    float val[6][8];
#pragma unroll
    for (int i = 0; i < 6; ++i) { const int it = (tid >> 4) + 32 * i, s = it >> 6, c = it & 63, tpos = n * 64 + c; const int col = s * 1024 + h * 128 + fr * 8;
      float y[8];
#pragma unroll
      for (int e = 0; e < 8; ++e) y[e] = 0.f;
#pragma unroll
      for (int j = 0; j < 4; ++j) { if (tpos - 3 + j >= 0) {
          const u32x4 xv = *(const u32x4*)(DQKV + (row0 + c - 3 + j) * 3072 + col); const f32x4 w0 = *(const f32x4*)(p.conv_w + (size_t)j * 3072 + col), w1 = *(const f32x4*)(p.conv_w + (size_t)j * 3072 + col + 4);
          y[0] += w0[0] * bflo(xv.x); y[1] += w0[1] * bfhi(xv.x); y[2] += w0[2] * bflo(xv.y); y[3] += w0[3] * bfhi(xv.y);
          y[4] += w1[0] * bflo(xv.z); y[5] += w1[1] * bfhi(xv.z); y[6] += w1[2] * bflo(xv.w); y[7] += w1[3] * bfhi(xv.w); } }
      float ss = 0.f;
#pragma unroll
      for (int e = 0; e < 8; ++e) { y[e] = siluf_(y[e]); ss += y[e] * y[e]; }
      ss = sum16(ss, lane);
      float scl = 1.f; if (s < 2) scl = 1.f / sqrtf(ss + 1e-6f); if (s == 0) scl *= 0.08838834764831845f;
#pragma unroll
      for (int e = 0; e < 8; ++e) val[i][e] = y[e] * scl; }
    __syncthreads();
    const float gclast = gcs[63];
#pragma unroll
    for (int i = 0; i < 6; ++i) { const int it = (tid >> 4) + 32 * i, s = it >> 6, c = it & 63; const float gc = gcs[c], be = betas[c];
      if (s == 0) { const float eg = __expf(gc);
        u32x4 a, d; a.x = pk2(val[i][0], val[i][1]); a.y = pk2(val[i][2], val[i][3]); a.z = pk2(val[i][4], val[i][5]); a.w = pk2(val[i][6], val[i][7]);
        d.x = pk2(val[i][0] * eg, val[i][1] * eg); d.y = pk2(val[i][2] * eg, val[i][3] * eg); d.z = pk2(val[i][4] * eg, val[i][5] * eg); d.w = pk2(val[i][6] * eg, val[i][7] * eg);
        *(LAS u32x4*)(lds + CP_Q + c * CP_RS + fr * 16) = a; *(u32x4*)(QD + ((size_t)bh * L_ + n * 64 + c) * 128 + fr * 8) = d;
      } else if (s == 1) { const float eb = be * __expf(gc), ed = __expf(gclast - gc);
        u32x4 a, d; a.x = pk2(val[i][0], val[i][1]); a.y = pk2(val[i][2], val[i][3]); a.z = pk2(val[i][4], val[i][5]); a.w = pk2(val[i][6], val[i][7]);
        d.x = pk2(val[i][0] * eb, val[i][1] * eb); d.y = pk2(val[i][2] * eb, val[i][3] * eb); d.z = pk2(val[i][4] * eb, val[i][5] * eb); d.w = pk2(val[i][6] * eb, val[i][7] * eb);
        *(LAS u32x4*)(lds + CP_K + c * CP_RS + fr * 16) = a; *(LAS u32x4*)(lds + CP_KG + c * CP_RS + fr * 16) = d;
        bf16_t* kt = KDT + ((size_t)unit * 128 + fr * 8) * 64 + c;
#pragma unroll
        for (int e = 0; e < 8; ++e) kt[e * 64] = (bf16_t)f2bf(val[i][e] * ed);
      } else { u32x4 d; d.x = pk2(val[i][0] * be, val[i][1] * be); d.y = pk2(val[i][2] * be, val[i][3] * be); d.z = pk2(val[i][4] * be, val[i][5] * be); d.w = pk2(val[i][6] * be, val[i][7] * be);
        *(LAS u32x4*)(lds + CP_VB + c * CP_RS + fr * 16) = d; } }
    __syncthreads();
    {
      const int rt = wave & 3; lds_t ap = lds + (wave < 4 ? CP_K : CP_Q) + (16 * rt + fr) * CP_RS + fq * 16;
      bf16x8 af[4];
#pragma unroll
      for (int ks = 0; ks < 4; ++ks) af[ks] = lds_ld16(ap + ks * 64);
#pragma unroll
      for (int ct = 0; ct < 4; ++ct) { f32x4 acc = {0.f, 0.f, 0.f, 0.f}; lds_t bp = lds + CP_K + (16 * ct + fr) * CP_RS + fq * 16;
#pragma unroll
        for (int ks = 0; ks < 4; ++ks) acc = MFMA16(af[ks], lds_ld16(bp + ks * 64), acc);
        const int s = 16 * ct + fr; const float gs = gcs[s];
#pragma unroll
        for (int j = 0; j < 4; ++j) { const int c = 16 * rt + 4 * fq + j; const float dec = __expf(gcs[c] - gs);
          if (wave < 4) Af[s * 68 + c] = (c > s) ? betas[c] * acc[j] * dec : 0.f;
          else QK[((size_t)unit * 64 + c) * 64 + s] = (bf16_t)f2bf((c >= s) ? acc[j] * dec : 0.f); } }
    }
    __syncthreads();
    if (wave == 0) {
      float t[64];
      unsigned abase = (unsigned)(size_t)Af; asm volatile("" : "+v"(abase));
#pragma unroll
      for (int i = 0; i < 64; ++i) t[i] = (lane == i) ? 1.f : 0.f;
      subst_rows<0>(t, abase);
#pragma unroll
      for (int i = 0; i < 64; ++i) *(LAS bf16_t*)(lds + CP_TB + i * 144 + lane * 2) = (bf16_t)f2bf(t[i]);
    }
    __syncthreads();
    {
      const int rt = wave & 3; lds_t tp = lds + CP_TB + (16 * rt + fr) * 144 + fq * 16;
      const bf16x8 a0 = lds_ld16(tp), a1 = lds_ld16(tp + 64);
      lds_t xb = lds + (wave < 4 ? CP_VB : CP_KG) + (fq * 8 + (fr >> 2)) * CP_RS + (fr & 3) * 8;
      bf16_t* og = (wave < 4 ? Ug : Wg) + ((size_t)bh * L_ + n * 64 + 16 * rt + 4 * fq) * 128 + fr;
#pragma unroll
      for (int ct = 0; ct < 8; ++ct) { f32x4 acc = {0.f, 0.f, 0.f, 0.f};
        { const s16x4 lo = lds_tr(xb + ct * 32), hi = lds_tr(xb + 4 * CP_RS + ct * 32); acc = MFMA16(a0, __builtin_shufflevector(lo, hi, 0, 1, 2, 3, 4, 5, 6, 7), acc); }
        { const s16x4 lo = lds_tr(xb + 32 * CP_RS + ct * 32), hi = lds_tr(xb + 36 * CP_RS + ct * 32); acc = MFMA16(a1, __builtin_shufflevector(lo, hi, 0, 1, 2, 3, 4, 5, 6, 7), acc); }
#pragma unroll
        for (int j = 0; j < 4; ++j) og[(size_t)j * 128 + ct * 16] = (bf16_t)f2bf(acc[j]); }
    }
  }
}
constexpr int CW_TB = 0  , CW_CH = 9216  , CW_RAW = 14336  , CW_AT = 0  , CW_TAB = 18624  , CW_WAVE = 19648;
constexpr size_t WS_QS = 52 * MiB;
DI void conv8(const bf16_t* base, unsigned eoff, int tpos, const f32x4 (&w)[4][2], float (&y)[8]) {
#pragma unroll
  for (int e = 0; e < 8; ++e) y[e] = 0.f;
#pragma unroll
  for (int j = 0; j < 4; ++j) if (tpos - 3 + j >= 0) { const u32x4 xv = *(const u32x4*)(base + (eoff + (unsigned)(j * 3072) - 9216u));
      y[0] += w[j][0][0] * bflo(xv.x); y[1] += w[j][0][1] * bfhi(xv.x); y[2] += w[j][0][2] * bflo(xv.y); y[3] += w[j][0][3] * bfhi(xv.y);
      y[4] += w[j][1][0] * bflo(xv.z); y[5] += w[j][1][1] * bfhi(xv.z); y[6] += w[j][1][2] * bflo(xv.w); y[7] += w[j][1][3] * bfhi(xv.w); }
#pragma unroll
  for (int e = 0; e < 8; ++e) y[e] = siluf_(y[e]);
}
DI void load_convw(const float* cw, int col, f32x4 (&w)[4][2]) {
#pragma unroll
  for (int j = 0; j < 4; ++j) { w[j][0] = *(const f32x4*)(cw + (size_t)j * 3072 + col); w[j][1] = *(const f32x4*)(cw + (size_t)j * 3072 + col + 4); }
}
DI bf16x8 pack_y(const float (&y)[8], float s) { u32x4 v; v.x = pk2(y[0] * s, y[1] * s); v.y = pk2(y[2] * s, y[3] * s); v.z = pk2(y[4] * s, y[5] * s); v.w = pk2(y[6] * s, y[7] * s); return __builtin_bit_cast(bf16x8, v); }
#define TRI(r, c) ((r) * ((r) + 1) / 2 + (c))
template <int J> DI void subst_rl(float (&t)[64], const f32x4 (&A)[10]) {
  if constexpr (J < 63) {
    const float xj = t[J];
#pragma unroll
    for (int i = J + 1; i < 64; ++i) {
      const float a = __builtin_bit_cast(float, __builtin_amdgcn_readlane(__builtin_bit_cast(int, A[TRI(i >> 4, J >> 4)][i & 3]), 16 * ((i & 15) >> 2) + (J & 15)));
      t[i] -= a * xj; }
    if constexpr ((J & 3) == 3) __builtin_amdgcn_sched_barrier(0);
    subst_rl<J + 1>(t, A);
  }
}
DI void raw_issue(u32x4 (&raw)[5], const bf16_t* DQKV, unsigned rowbase  , int n64, int colbase, int ln) {
  asm volatile("" : "+v"(ln));
#pragma unroll
  for (int i = 0; i < 5; ++i) { const int item = ln + 64 * i, rr = item >> 2, pc = item & 3; raw[i] = (u32x4){0u, 0u, 0u, 0u};
    if (item < 268 && n64 - 3 + rr >= 0) raw[i] = *(const u32x4*)(DQKV + ((rowbase + (unsigned)rr) * 3072u + (unsigned)(colbase + pc * 8))); }
}
DI void raw_commit(lds_t rawl, const u32x4 (&raw)[5], int ln) {
  asm volatile("" : "+v"(ln));
#pragma unroll
  for (int i = 0; i < 5; ++i) { const int item = ln + 64 * i; if (item < 268) *(LAS u32x4*)(rawl + item * 16) = raw[i]; }
  asm volatile("" ::: "memory");
}
DI void conv8l(lds_t rawl, int c, int fq, const f32x4 (&w)[4][2], float (&y)[8]) {
#pragma unroll
  for (int e = 0; e < 8; ++e) y[e] = 0.f;
#pragma unroll
  for (int j = 0; j < 4; ++j) { const u32x4 xv = *(LAS u32x4*)(rawl + (c + j) * 64 + fq * 16);
    y[0] += w[j][0][0] * bflo(xv.x); y[1] += w[j][0][1] * bfhi(xv.x); y[2] += w[j][0][2] * bflo(xv.y); y[3] += w[j][0][3] * bfhi(xv.y);
    y[4] += w[j][1][0] * bflo(xv.z); y[5] += w[j][1][1] * bfhi(xv.z); y[6] += w[j][1][2] * bflo(xv.w); y[7] += w[j][1][3] * bfhi(xv.w); }
#pragma unroll
  for (int e = 0; e < 8; ++e) y[e] = siluf_(y[e]);
}
#ifndef NCM
#define NCM 63
#endif
DI void chunkprep_wave(const Params& p, lds_t lds, int wv) {
  const int wave = wv;
  unsigned char* ws = p.ws;
  const bf16_t* DQKV = (const bf16_t*)(ws + WS_DQKV); const float* BG = (const float*)(ws + WS_BG);
  bf16_t* Qg = (bf16_t*)(ws + WS_QD); bf16_t* KDT = (bf16_t*)(ws + WS_KDT); bf16_t* Ug = (bf16_t*)(ws + WS_U); bf16_t* Wg = (bf16_t*)(ws + WS_W);
  bf16_t* QK = (bf16_t*)((unsigned char*)p.out + DO_QK); float* GL = (float*)(ws + WS_GL); float* QS = (float*)(ws + WS_QS);
  lds_t wl = lds + wave * CW_WAVE; LAS float* tab = (LAS float*)(wl + CW_TAB);
  for (int unit = blockIdx.x * 8 + wave; unit < 4096; unit += gridDim.x * 8) {
    const int ln = lane_id();
    const int fr = ln & 15, fq = ln >> 4;
    const int bh = unit >> 6, n = unit & 63, b = bh >> 3, h = bh & 7;
    const size_t row0 = (size_t)b * L_ + n * 64, trow0 = (size_t)bh * L_ + n * 64;
    float gclast;
    { const float db = BG[((unsigned)row0 + ln) * 16u + h], da = BG[((unsigned)row0 + ln) * 16u + 8 + h];
      const float xx = da + p.dt_bias[h]; const float sp = (xx > 20.f) ? xx : __logf(1.f + __expf(xx));
      float gg = -__expf(p.a_log[h]) * sp;
#pragma unroll
      for (int o = 1; o < 64; o <<= 1) { const float tt = BPERM((ln - o) & 63, gg); if (ln >= o) gg += tt; }
      tab[ln] = gg; tab[64 + ln] = sigmoidf_(db); gclast = __builtin_bit_cast(float, __builtin_amdgcn_readlane(__builtin_bit_cast(int, gg), 63));
      if ((NCM & 32) && ln == 63) GL[unit] = __expf(gg); }
#ifndef CPW
#define CPW 255
#endif
    f32x4 A[10]; u32x4 raw[5];
    const unsigned rowbase = (unsigned)row0 - 3u; const int kcol0 = 1024 + h * 128, qcol0 = h * 128, vcol0 = 2048 + h * 128;
    raw_issue(raw, DQKV, rowbase, n * 64, kcol0, ln);
    { f32x4 gq[10];
#pragma unroll
      for (int i = 0; i < 10; ++i) { A[i] = (f32x4){0.f, 0.f, 0.f, 0.f}; gq[i] = (f32x4){0.f, 0.f, 0.f, 0.f}; }
      float ssk[4] = {0.f, 0.f, 0.f, 0.f}, ssq[4] = {0.f, 0.f, 0.f, 0.f};
#pragma unroll 1
      for (int ks = 0; ks < 4; ++ks) {
        bf16x8 kc[4], qc[4];
        { const int col = 1024 + h * 128 + 32 * ks + 8 * fq; f32x4 w[4][2]; load_convw(p.conv_w, col, w);
          raw_commit(wl + CW_RAW, raw, ln); raw_issue(raw, DQKV, rowbase, n * 64, qcol0 + 32 * ks, ln);
#pragma unroll
          for (int rt = 0; rt < 4; ++rt) { float y[8]; conv8l(wl + CW_RAW, 16 * rt + fr, fq, w, y);
#pragma unroll
            for (int e = 0; e < 8; ++e) ssk[rt] += y[e] * y[e];
            kc[rt] = pack_y(y, 1.f); __builtin_amdgcn_sched_barrier(0); } }
        __builtin_amdgcn_sched_barrier(0);
        { const int col = h * 128 + 32 * ks + 8 * fq; f32x4 w[4][2]; load_convw(p.conv_w, col, w);
          raw_commit(wl + CW_RAW, raw, ln); raw_issue(raw, DQKV, rowbase, n * 64, (ks < 3) ? kcol0 + 32 * (ks + 1) : vcol0, ln);
#pragma unroll
          for (int rt = 0; rt < 4; ++rt) { float y[8]; conv8l(wl + CW_RAW, 16 * rt + fr, fq, w, y);
#pragma unroll
            for (int e = 0; e < 8; ++e) ssq[rt] += y[e] * y[e];
            qc[rt] = pack_y(y, 1.f);
            { const int lq = lane_id(); if (NCM & 1) *(bf16x8*)(Qg + (((unsigned)trow0 + 16 * rt + (lq & 15)) * 128u + 32 * ks + 8 * (lq >> 4))) = qc[rt]; } __builtin_amdgcn_sched_barrier(0); } }
        __builtin_amdgcn_sched_barrier(0);
#pragma unroll
        for (int rt = 0; rt < 4; ++rt)
#pragma unroll
          for (int ct = 0; ct <= rt; ++ct) { A[TRI(rt, ct)] = MFMA16(kc[rt], kc[ct], A[TRI(rt, ct)]); gq[TRI(rt, ct)] = MFMA16(qc[rt], kc[ct], gq[TRI(rt, ct)]); }
        __builtin_amdgcn_sched_barrier(0);
      }
      int lnr_ = lane_id(); unsigned wlru = (unsigned)(size_t)lds + (unsigned)(wave * CW_WAVE); asm volatile("" : "+s"(wlru));
      { const int ln = lnr_, fr = ln & 15, fq = ln >> 4; const lds_t wl = (lds_t)(size_t)wlru; LAS float* tab = (LAS float*)(wl + CW_TAB);
#pragma unroll
      for (int rt = 0; rt < 4; ++rt) { float s = ssk[rt]; s += BPERM(ln ^ 16, s); s += BPERM(ln ^ 32, s); float q = ssq[rt]; q += BPERM(ln ^ 16, q); q += BPERM(ln ^ 32, q);
        const float rq = 0.08838834764831845f / sqrtf(q + 1e-6f);
        if (fq == 0) { tab[128 + 16 * rt + fr] = 1.f / sqrtf(s + 1e-6f); tab[192 + 16 * rt + fr] = rq; if (NCM & 1) QS[(unsigned)trow0 + 16 * rt + fr] = rq * __expf(tab[16 * rt + fr]); } }
      }
      asm volatile("" ::: "memory");
      { int lns_ = lane_id(); const int fr = lns_ & 15, fq = lns_ >> 4; unsigned wlsu = (unsigned)(size_t)lds + (unsigned)(wave * CW_WAVE); asm volatile("" : "+s"(wlsu)); const lds_t wl = (lds_t)(size_t)wlsu; LAS float* tab = (LAS float*)(wl + CW_TAB);
#pragma unroll
      for (int rt = 0; rt < 4; ++rt) {
        float gcr[4], ber[4], rkr[4], rqr[4];
#pragma unroll
        for (int j = 0; j < 4; ++j) { const int c = 16 * rt + 4 * fq + j; gcr[j] = tab[c]; ber[j] = tab[64 + c]; rkr[j] = tab[128 + c]; rqr[j] = tab[192 + c]; }
#pragma unroll
        for (int ct = 0; ct < 4; ++ct) {
          bf16_t* qko = QK + (((unsigned)unit * 64 + 16 * rt + 4 * fq) * 64u + 16 * ct + fr);
          if (ct > rt) {
#pragma unroll
            for (int j = 0; j < 4; ++j) { if (NCM & 2) qko[j * 64] = 0; *(LAS float*)(wl + CW_AT + ((16 * ct + fr) * 68 + 16 * rt + 4 * fq + j) * 4) = 0.f; }
            continue; }
          const int s = 16 * ct + fr; const float gs = tab[s], rks = tab[128 + s];
#pragma unroll
          for (int j = 0; j < 4; ++j) { const int c = 16 * rt + 4 * fq + j; const float dec = __expf(gcr[j] - gs) * rks;
            A[TRI(rt, ct)][j] = (c > s) ? A[TRI(rt, ct)][j] * rkr[j] * ber[j] * dec : 0.f;
            *(LAS float*)(wl + CW_AT + (s * 68 + c) * 4) = A[TRI(rt, ct)][j];
            if (NCM & 2) qko[j * 64] = (bf16_t)f2bf((c >= s) ? gq[TRI(rt, ct)][j] * rqr[j] * dec : 0.f); } } }
      }
    }
    __builtin_amdgcn_sched_barrier(0);
#if CPW & 4
    { float t[64]; const int ln = lane_id();
#pragma unroll
      for (int i = 0; i < 64; ++i) t[i] = (ln == i) ? 1.f : 0.f;
      asm volatile("" ::: "memory");
      { unsigned abase = (unsigned)(size_t)(wl + CW_AT); asm volatile("" : "+v"(abase)); subst_rows<0>(t, abase); }
      asm volatile("" ::: "memory");
#pragma unroll
      for (int i = 0; i < 64; ++i) *(LAS bf16_t*)(wl + CW_TB + i * 144 + ln * 2) = (bf16_t)f2bf(t[i]);
      asm volatile("" ::: "memory"); }
#endif
    __builtin_amdgcn_sched_barrier(0);
    int ln8 = lane_id(); { const int fr = ln8 & 15, fq = ln8 >> 4; unsigned wl8u = (unsigned)(size_t)lds + (unsigned)(wave * CW_WAVE); asm volatile("" : "+s"(wl8u)); const lds_t wl = (lds_t)(size_t)wl8u; LAS float* tab = (LAS float*)(wl + CW_TAB);
    bf16x8 ta[4][2];
#pragma unroll
    for (int rt = 0; rt < 4; ++rt) { ta[rt][0] = lds_ld16(wl + CW_TB + (16 * rt + fr) * 144 + fq * 16); ta[rt][1] = lds_ld16(wl + CW_TB + (16 * rt + fr) * 144 + 64 + fq * 16); }
    lds_t chw = wl + CW_CH + fr * 80 + fq * 16;
    lds_t chr = wl + CW_CH + (8 * fq + (fr >> 2)) * 80 + (fr & 3) * 8;
#if CPW & 1
#pragma unroll 1
    for (int ks = 0; ks < 4; ++ks) { const int col = 2048 + h * 128 + 32 * ks + 8 * fq; f32x4 w[4][2]; load_convw(p.conv_w, col, w);
      raw_commit(wl + CW_RAW, raw, ln8); raw_issue(raw, DQKV, rowbase, n * 64, (ks < 3) ? vcol0 + 32 * (ks + 1) : kcol0, ln8);
#pragma unroll
      for (int rt = 0; rt < 4; ++rt) { float y[8]; conv8l(wl + CW_RAW, 16 * rt + fr, fq, w, y);
        *(LAS bf16x8*)(chw + rt * 1280) = pack_y(y, tab[64 + 16 * rt + fr]); if (rt & 1) __builtin_amdgcn_sched_barrier(0); }
      asm volatile("" ::: "memory");
#pragma unroll
      for (int ct2 = 0; ct2 < 2; ++ct2) {
        const s16x4 l0 = lds_tr(chr + ct2 * 32), h0 = lds_tr(chr + 320 + ct2 * 32), l1 = lds_tr(chr + 2560 + ct2 * 32), h1 = lds_tr(chr + 2880 + ct2 * 32);
        const bf16x8 b0 = __builtin_shufflevector(l0, h0, 0, 1, 2, 3, 4, 5, 6, 7), b1 = __builtin_shufflevector(l1, h1, 0, 1, 2, 3, 4, 5, 6, 7);
#pragma unroll
        for (int rt = 0; rt < 4; ++rt) { f32x4 acc = {0.f, 0.f, 0.f, 0.f}; acc = MFMA16(ta[rt][0], b0, acc); acc = MFMA16(ta[rt][1], b1, acc);
          { u32x2 uv2; uv2.x = pk2(acc[0], acc[1]); uv2.y = pk2(acc[2], acc[3]);
            if (NCM & 4) *(u32x2*)(Ug + ((((unsigned)unit * 4 + ks) * 4 + rt) * 64 + ln8) * 8u + ct2 * 4) = uv2; } } }
      __builtin_amdgcn_sched_barrier(0); }
#endif
    __builtin_amdgcn_sched_barrier(0);
#if CPW & 2
#pragma unroll 1
    for (int ks = 0; ks < 4; ++ks) { const int col = 1024 + h * 128 + 32 * ks + 8 * fq; f32x4 w[4][2]; load_convw(p.conv_w, col, w);
      bf16x8 kd[4];
      raw_commit(wl + CW_RAW, raw, ln8); if (ks < 3) raw_issue(raw, DQKV, rowbase, n * 64, kcol0 + 32 * (ks + 1), ln8);
#pragma unroll
      for (int rt = 0; rt < 4; ++rt) { float y[8]; conv8l(wl + CW_RAW, 16 * rt + fr, fq, w, y);
        const int c = 16 * rt + fr; const float gc = tab[c], rk = tab[128 + c];
        *(LAS bf16x8*)(chw + rt * 1280) = pack_y(y, rk * tab[64 + c] * __expf(gc)); kd[rt] = pack_y(y, rk * __expf(gclast - gc)); if (rt & 1) __builtin_amdgcn_sched_barrier(0); }
      asm volatile("" ::: "memory");
#pragma unroll
      for (int ct2 = 0; ct2 < 2; ++ct2) {
        const s16x4 l0 = lds_tr(chr + ct2 * 32), h0 = lds_tr(chr + 320 + ct2 * 32), l1 = lds_tr(chr + 2560 + ct2 * 32), h1 = lds_tr(chr + 2880 + ct2 * 32);
        const bf16x8 b0 = __builtin_shufflevector(l0, h0, 0, 1, 2, 3, 4, 5, 6, 7), b1 = __builtin_shufflevector(l1, h1, 0, 1, 2, 3, 4, 5, 6, 7);
#pragma unroll
        for (int rt = 0; rt < 4; ++rt) { f32x4 acc = {0.f, 0.f, 0.f, 0.f}; acc = MFMA16(b0, ta[rt][0], acc); acc = MFMA16(b1, ta[rt][1], acc);
          u32x2 wv2; wv2.x = pk2(acc[0], acc[1]); wv2.y = pk2(acc[2], acc[3]);
          if (NCM & 8) *(u32x2*)(Wg + (((unsigned)trow0 + 16 * rt + fr) * 128u + 32 * ks + 16 * ct2 + 4 * fq)) = wv2; } }
      asm volatile("" ::: "memory");
#pragma unroll
      for (int rt = 0; rt < 4; ++rt) *(LAS bf16x8*)(chw + rt * 1280) = kd[rt];
      asm volatile("" ::: "memory");
#pragma unroll
      for (int ct2 = 0; ct2 < 2; ++ct2)
#pragma unroll
        for (int ks2 = 0; ks2 < 2; ++ks2) { const s16x4 lo = lds_tr(chr + ks2 * 2560 + ct2 * 32), hi = lds_tr(chr + ks2 * 2560 + 320 + ct2 * 32);
          if (NCM & 16) *(bf16x8*)(KDT + (((unsigned)unit * 128 + 32 * ks + 16 * ct2 + fr) * 64u + 32 * ks2 + 8 * fq)) = __builtin_shufflevector(lo, hi, 0, 1, 2, 3, 4, 5, 6, 7); }
      asm volatile("" ::: "memory"); __builtin_amdgcn_sched_barrier(0); }
#endif
    }
  }
}
constexpr int SC_ST = 0  , SC_VT = 8704  ;
template <int LMUL> DI void scan_phase(const Params& p, lds_t lds, int wv) { TIDS();
  unsigned char* ws = p.ws;
  const bf16_t* QD = (const bf16_t*)(ws + WS_QD); const bf16_t* KDT = (const bf16_t*)(ws + WS_KDT); const bf16_t* Ug = (const bf16_t*)(ws + WS_U); const bf16_t* Wg = (const bf16_t*)(ws + WS_W);
  const bf16_t* QK = (const bf16_t*)((const unsigned char*)p.out + DO_QK); const float* GL = (const float*)(ws + WS_GL); bf16_t* ORAW = (bf16_t*)(ws + WS_ORAW); const float* QS = (const float*)(ws + WS_QS);
  const int fr = lane & 15, fq = lane >> 4, rt = wave & 3;
  for (int unit0 = blockIdx.x; unit0 < 256; unit0 += gridDim.x) {
    const int unit = (gridDim.x == 256) ? ((((unit0 & 7) * 8 + (unit0 >> 5)) << 2) | ((unit0 >> 3) & 3)) : unit0;
    const int bh = unit >> 2, sl = unit & 3, b = bh >> 3, h = bh & 7;
    __syncthreads();
    for (int i = tid; i < (8704 + 4608) / 4; i += 512) ((LAS unsigned*)lds)[i] = 0u;
    f32x4 sacc[2] = {{0.f, 0.f, 0.f, 0.f}, {0.f, 0.f, 0.f, 0.f}};
    const bf16_t* arow = (wave < 4 ? Wg : QD) + ((size_t)bh * L_ + 16 * rt + fr) * 128 + fq * 8;
    const bf16_t* krow = KDT + ((size_t)bh * 64 * 128 + 16 * wave + fr) * 64 + fq * 8;
    const bf16_t* qkrow = QK + ((size_t)bh * 64 * 64 + 16 * rt + fr) * 64 + fq * 8;
    const size_t qkstep = (wave >= 4) ? 4096 : 0, ustep = (wave < 4) ? 8192 : 0, qsstep = (wave >= 4) ? 64 : 0;
    const bf16_t* urow = Ug + ((size_t)((bh * 64) * 4 + sl) * 4 + rt) * 512 + lane * 8;
    const float* qsrow = QS + (size_t)bh * L_ + 16 * rt + 4 * fq;
    bf16_t* orow = ORAW + ((size_t)b * L_ + 16 * rt + 4 * fq) * 1024 + h * 128 + sl * 32 + fr;
    bf16_t* obase = (wave >= 4) ? orow : (bf16_t*)(ws + 54 * MiB) + ((size_t)blockIdx.x * 4 + wave) * 2048 + 32 * fq + fr;     const size_t ostep = (wave >= 4) ? 65536 : 0;
#define SC_DECL(B) bf16x8 B##af[4], B##kf[2], B##qk[2]; u32x4 B##uq; f32x4 B##qs; float B##gl
#define SC_LOADB(B, nn0) do { const int nn = (nn0) * LMUL; _Pragma("unroll") for (int ks = 0; ks < 4; ++ks) B##af[ks] = *(const bf16x8*)(arow + (size_t)(nn) * 8192 + ks * 32); \
      _Pragma("unroll") for (int ks = 0; ks < 2; ++ks) { B##kf[ks] = *(const bf16x8*)(krow + (size_t)(nn) * 8192 + ks * 32); B##qk[ks] = *(const bf16x8*)(qkrow + (size_t)(nn) * qkstep + ks * 32); } \
      B##uq = *(const u32x4*)(urow + (size_t)(nn) * ustep); \
      B##qs = *(const f32x4*)(qsrow + (size_t)(nn) * qsstep); \
      B##gl = __builtin_bit_cast(float, __builtin_amdgcn_readlane(__builtin_bit_cast(int, glv), (nn))); } while (0)
#define SC_BAR() do { asm volatile("s_waitcnt lgkmcnt(0)" ::: "memory"); __builtin_amdgcn_s_barrier(); asm volatile("" ::: "memory"); } while (0)
#define SC_STEP(B, nn) do { \
      f32x4 acc[2]; bf16x8 sb[2][4]; \
      _Pragma("unroll") for (int ct = 0; ct < 2; ++ct) { acc[ct] = (f32x4){0.f, 0.f, 0.f, 0.f}; lds_t sp = lds + SC_ST + (16 * ct + fr) * 272 + fq * 16; \
        _Pragma("unroll") for (int ks = 0; ks < 4; ++ks) sb[ct][ks] = lds_ld16(sp + ks * 64); } \
      __builtin_amdgcn_sched_barrier(0); \
      _Pragma("unroll") for (int ks = 0; ks < 4; ++ks) { acc[0] = MFMA16(B##af[ks], sb[0][ks], acc[0]); acc[1] = MFMA16(B##af[ks], sb[1][ks], acc[1]); } \
      __builtin_amdgcn_sched_barrier(0); \
      if (wave < 4) { \
        { u32x2 v; v.x = pk2(bflo(B##uq.x) - acc[0][0], bfhi(B##uq.x) - acc[0][1]); v.y = pk2(bflo(B##uq.y) - acc[0][2], bfhi(B##uq.y) - acc[0][3]); \
          *(LAS u32x2*)(lds + SC_VT + fr * 144 + (16 * rt + 4 * fq) * 2) = v; \
          v.x = pk2(bflo(B##uq.z) - acc[1][0], bfhi(B##uq.z) - acc[1][1]); v.y = pk2(bflo(B##uq.w) - acc[1][2], bfhi(B##uq.w) - acc[1][3]); \
          *(LAS u32x2*)(lds + SC_VT + (16 + fr) * 144 + (16 * rt + 4 * fq) * 2) = v; } } \
      SC_BAR(); \
      bf16x8 vb[2][2]; \
      _Pragma("unroll") for (int ct = 0; ct < 2; ++ct) _Pragma("unroll") for (int ks = 0; ks < 2; ++ks) vb[ct][ks] = lds_ld16(lds + SC_VT + (16 * ct + fr) * 144 + ks * 64 + fq * 16); \
      { bf16_t* op = obase + (size_t)(nn) * ostep;     \
        _Pragma("unroll") for (int ct = 0; ct < 2; ++ct) { \
          _Pragma("unroll") for (int j = 0; j < 4; ++j) acc[ct][j] *= B##qs[j]; \
          _Pragma("unroll") for (int ks = 0; ks < 2; ++ks) acc[ct] = MFMA16(B##qk[ks], vb[ct][ks], acc[ct]); \
          _Pragma("unroll") for (int j = 0; j < 4; ++j) op[(size_t)j * 1024 + ct * 16] = (bf16_t)f2bf(acc[ct][j]); } } \
      _Pragma("unroll") for (int ct = 0; ct < 2; ++ct) { sacc[ct] = sacc[ct] * B##gl; \
        _Pragma("unroll") for (int ks = 0; ks < 2; ++ks) sacc[ct] = MFMA16(B##kf[ks], vb[ct][ks], sacc[ct]); \
        u32x2 v; v.x = pk2(sacc[ct][0], sacc[ct][1]); v.y = pk2(sacc[ct][2], sacc[ct][3]); \
        *(LAS u32x2*)(lds + SC_ST + (16 * ct + fr) * 272 + (16 * wave + 4 * fq) * 2) = v; } \
      if ((nn) + 3 < 64) SC_LOADB(B, (nn) + 3); \
      SC_BAR(); } while (0)
    const float glv = GL[bh * 64 + lane];
    SC_DECL(b0); SC_DECL(b1); SC_DECL(b2);
    SC_LOADB(b0, 0); SC_LOADB(b1, 1); SC_LOADB(b2, 2);
    __syncthreads();
    for (int n = 0; n < 63; n += 3) { SC_STEP(b0, n); SC_STEP(b1, n + 1); SC_STEP(b2, n + 2); }
    SC_STEP(b0, 63);
#undef SC_DECL
#undef SC_LOADB
#undef SC_BAR
#undef SC_STEP
  }
}
DI void gate_phase(const Params& p, int wv) { TIDS();
  const bf16_t* ORAW = (const bf16_t*)(p.ws + WS_ORAW); const bf16_t* ZG = (const bf16_t*)(p.ws + WS_ZG); bf16_t* OA = (bf16_t*)(p.ws + WS_OA);
  const int fr = tid & 15;
  const f32x4 w0 = *(const f32x4*)(p.dn_norm_w + fr * 8), w1 = *(const f32x4*)(p.dn_norm_w + fr * 8 + 4);
  for (size_t it = (size_t)blockIdx.x * 512 + tid; it < (size_t)T_ * 128; it += (size_t)gridDim.x * 512) {
    const size_t off = it * 8;
    const u32x4 q = *(const u32x4*)(ORAW + off);
    const f32x4 a0 = {bflo(q.x), bfhi(q.x), bflo(q.y), bfhi(q.y)}, a1 = {bflo(q.z), bfhi(q.z), bflo(q.w), bfhi(q.w)};
    float ss = (a0[0] * a0[0] + a0[1] * a0[1]) + (a0[2] * a0[2] + a0[3] * a0[3]) + (a1[0] * a1[0] + a1[1] * a1[1]) + (a1[2] * a1[2] + a1[3] * a1[3]);
    ss = sum16(ss, lane);
    const float r = 1.f / sqrtf(ss * (1.f / 128.f) + 1e-6f);
    const size_t row = it >> 7; const int col = (int)(it & 127) * 8;
    const u32x4 z = *(const u32x4*)(ZG + row * 3072 + col);
    u32x4 o;
    o.x = pk2(a0[0] * r * w0[0] * siluf_(bflo(z.x)), a0[1] * r * w0[1] * siluf_(bfhi(z.x)));
    o.y = pk2(a0[2] * r * w0[2] * siluf_(bflo(z.y)), a0[3] * r * w0[3] * siluf_(bfhi(z.y)));
    o.z = pk2(a1[0] * r * w1[0] * siluf_(bflo(z.z)), a1[1] * r * w1[1] * siluf_(bfhi(z.z)));
    o.w = pk2(a1[2] * r * w1[2] * siluf_(bflo(z.w)), a1[3] * r * w1[3] * siluf_(bfhi(z.w)));
    *(u32x4*)(OA + off) = o;
  }
}
constexpr size_t WS_X2B = S5;
DI void final_norm_phase(const Params& p, int wv) { TIDS();
  const int gw = blockIdx.x * 8 + wave, NGW = gridDim.x * 8;
  const bf16_t* X2 = (const bf16_t*)(p.ws + WS_X2B);
  const f32x4* wr = (const f32x4*)p.final_norm_w + lane * 2;
  const f32x4 g0 = wr[0], g1 = wr[1], g2 = wr[128], g3 = wr[129];
  for (int m = gw; m < T_; m += 2 * NGW) { const int m2 = (m + NGW < T_) ? m + NGW : m;
    const u32x4 a0 = *((const u32x4*)(X2 + (size_t)m * D_) + lane), a1 = *((const u32x4*)(X2 + (size_t)m * D_) + 64 + lane);
    const u32x4 b0 = *((const u32x4*)(X2 + (size_t)m2 * D_) + lane), b1 = *((const u32x4*)(X2 + (size_t)m2 * D_) + 64 + lane);
    const f32x4 va0 = {bflo(a0.x), bfhi(a0.x), bflo(a0.y), bfhi(a0.y)}, va1 = {bflo(a0.z), bfhi(a0.z), bflo(a0.w), bfhi(a0.w)}, va2 = {bflo(a1.x), bfhi(a1.x), bflo(a1.y), bfhi(a1.y)}, va3 = {bflo(a1.z), bfhi(a1.z), bflo(a1.w), bfhi(a1.w)};
    const f32x4 vb0 = {bflo(b0.x), bfhi(b0.x), bflo(b0.y), bfhi(b0.y)}, vb1 = {bflo(b0.z), bfhi(b0.z), bflo(b0.w), bfhi(b0.w)}, vb2 = {bflo(b1.x), bfhi(b1.x), bflo(b1.y), bfhi(b1.y)}, vb3 = {bflo(b1.z), bfhi(b1.z), bflo(b1.w), bfhi(b1.w)};
    const f32x4 qa = va0 * va0 + va1 * va1 + va2 * va2 + va3 * va3, qb = vb0 * vb0 + vb1 * vb1 + vb2 * vb2 + vb3 * vb3;
    const float ra = 1.f / sqrtf(wave_sum((qa[0] + qa[1]) + (qa[2] + qa[3]), lane) * (1.f / 1024.f) + 1e-6f), rb = 1.f / sqrtf(wave_sum((qb[0] + qb[1]) + (qb[2] + qb[3]), lane) * (1.f / 1024.f) + 1e-6f);
    f32x4* oa = (f32x4*)(p.out + (size_t)m * D_) + lane * 2; f32x4* ob = (f32x4*)(p.out + (size_t)m2 * D_) + lane * 2;
    oa[0] = va0 * ra * g0; oa[1] = va1 * ra * g1; oa[128] = va2 * ra * g2; oa[129] = va3 * ra * g3;
    ob[0] = vb0 * rb * g0; ob[1] = vb1 * rb * g1; ob[128] = vb2 * rb * g2; ob[129] = vb3 * rb * g3; }
}
DI void norm2_phase(const Params& p, int wv) { TIDS();
  const int gw = blockIdx.x * 8 + wave, NGW = gridDim.x * 8;
  const bf16_t* X1 = (const bf16_t*)(p.ws + WS_X1); bf16_t* H2 = (bf16_t*)(p.ws + WS_H2);
  const f32x4* wr = (const f32x4*)p.norm2_w + lane * 2;
  const f32x4 g0 = wr[0], g1 = wr[1], g2 = wr[128], g3 = wr[129];
  for (int m = gw; m < T_; m += 2 * NGW) { const int m2 = (m + NGW < T_) ? m + NGW : m;
    const u32x4 a0 = *((const u32x4*)(X1 + (size_t)m * D_) + lane), a1 = *((const u32x4*)(X1 + (size_t)m * D_) + 64 + lane);
    const u32x4 b0 = *((const u32x4*)(X1 + (size_t)m2 * D_) + lane), b1 = *((const u32x4*)(X1 + (size_t)m2 * D_) + 64 + lane);
    float va[16], vb[16];
#define UNP(dst, o, q) dst[o] = bflo(q.x); dst[o + 1] = bfhi(q.x); dst[o + 2] = bflo(q.y); dst[o + 3] = bfhi(q.y); dst[o + 4] = bflo(q.z); dst[o + 5] = bfhi(q.z); dst[o + 6] = bflo(q.w); dst[o + 7] = bfhi(q.w)
    UNP(va, 0, a0); UNP(va, 8, a1); UNP(vb, 0, b0); UNP(vb, 8, b1);
#undef UNP
    float sa = 0.f, sb = 0.f;
#pragma unroll
    for (int e = 0; e < 16; ++e) { sa += va[e] * va[e]; sb += vb[e] * vb[e]; }
    const float ra = 1.f / sqrtf(wave_sum(sa, lane) * (1.f / 1024.f) + 1e-6f), rb = 1.f / sqrtf(wave_sum(sb, lane) * (1.f / 1024.f) + 1e-6f);
    const float gg[16] = {g0[0], g0[1], g0[2], g0[3], g1[0], g1[1], g1[2], g1[3], g2[0], g2[1], g2[2], g2[3], g3[0], g3[1], g3[2], g3[3]};
    u32x4 oa0, oa1, ob0, ob1;
    oa0.x = pk2(va[0] * ra * gg[0], va[1] * ra * gg[1]); oa0.y = pk2(va[2] * ra * gg[2], va[3] * ra * gg[3]); oa0.z = pk2(va[4] * ra * gg[4], va[5] * ra * gg[5]); oa0.w = pk2(va[6] * ra * gg[6], va[7] * ra * gg[7]);
    oa1.x = pk2(va[8] * ra * gg[8], va[9] * ra * gg[9]); oa1.y = pk2(va[10] * ra * gg[10], va[11] * ra * gg[11]); oa1.z = pk2(va[12] * ra * gg[12], va[13] * ra * gg[13]); oa1.w = pk2(va[14] * ra * gg[14], va[15] * ra * gg[15]);
    ob0.x = pk2(vb[0] * rb * gg[0], vb[1] * rb * gg[1]); ob0.y = pk2(vb[2] * rb * gg[2], vb[3] * rb * gg[3]); ob0.z = pk2(vb[4] * rb * gg[4], vb[5] * rb * gg[5]); ob0.w = pk2(vb[6] * rb * gg[6], vb[7] * rb * gg[7]);
    ob1.x = pk2(vb[8] * rb * gg[8], vb[9] * rb * gg[9]); ob1.y = pk2(vb[10] * rb * gg[10], vb[11] * rb * gg[11]); ob1.z = pk2(vb[12] * rb * gg[12], vb[13] * rb * gg[13]); ob1.w = pk2(vb[14] * rb * gg[14], vb[15] * rb * gg[15]);
    *((u32x4*)(H2 + (size_t)m * D_) + lane) = oa0; *((u32x4*)(H2 + (size_t)m * D_) + 64 + lane) = oa1;
    *((u32x4*)(H2 + (size_t)m2 * D_) + lane) = ob0; *((u32x4*)(H2 + (size_t)m2 * D_) + 64 + lane) = ob1; }
}
#define GEMM_PHASE(EpiT, Aptr, Bptr, Nn, Kk, ...) do { pg8::Gemm g_{(const bf16_t*)(Aptr), (const bf16_t*)(Bptr), T_, (Nn), (Kk), wv}; pg8::StaticOrder S_; S_.init(T_, (Nn), (int)gridDim.x, (int)blockIdx.x); \
    EpiT E_{__VA_ARGS__}; pg8::gemm_phase<EpiT, pg8::StaticOrder, PG8_ALIGN, PG8_SP2>((PG8_LAS unsigned char*)lds, g_, S_, E_); } while (0)
#ifndef REP_P0
#define REP_P0 1
#endif
#ifndef REP_ATTN
#define REP_ATTN 1
#endif
#ifndef REP_CP
#define REP_CP 1
#endif
#ifndef REP_SCAN
#define REP_SCAN 1
#endif
#ifndef REP_EW
#define REP_EW 1
#endif
#ifndef REP_GEMM
#define REP_GEMM 1
#endif
#define XB_TMO      128
#define XB_XCNT(j)  (256  + 64 * (j))
#define XB_XSUB(j)  (1280 + 64 * (j))
#define XB_XGEN(j)  (2304 + 64 * (j))
#define XB_TOP      3328
#define XB_TOPGEN   3392
#define XCD_BAR_WORDS 3456
#define XB_SPIN_CAP (1u << 18)

__device__ __forceinline__ unsigned xb_ld(unsigned* p)              { return __hip_atomic_load(p, __ATOMIC_RELAXED, __HIP_MEMORY_SCOPE_AGENT); }
__device__ __forceinline__ unsigned xb_add(unsigned* p, unsigned v) { return __hip_atomic_fetch_add(p, v, __ATOMIC_RELAXED, __HIP_MEMORY_SCOPE_AGENT); }
__device__ __forceinline__ unsigned xb_xcc_id() { return (unsigned)__builtin_amdgcn_s_getreg((3 << 11) | 20) & 0xFu; }
#define XB_SPIN(cond, bar) do { unsigned _sp = 0; while (cond) { __builtin_amdgcn_s_sleep(1); \
    if ((++_sp & 255u) == 0u) { if (xb_ld(&(bar)[XB_TMO])) break; if (_sp > XB_SPIN_CAP) { atomicAdd(&(bar)[XB_TMO], 1u); break; } } } } while (0)

struct XcdBarrier {
    int wv;
    unsigned* bar; unsigned x;
    volatile LAS unsigned* st;
};

__device__ __forceinline__ XcdBarrier xcd_barrier_post(unsigned* bar, volatile LAS unsigned* st) {
    XcdBarrier b; b.bar = bar; b.x = xb_xcc_id(); b.st = st; b.wv = 0;
    if (threadIdx.x == 0) (void)xb_add(&bar[XB_XCNT(b.x)], 1u);
    return b;
}
__device__ __forceinline__ void xcd_barrier_complete(unsigned* bar, unsigned x, unsigned& nloc, unsigned& nx) {
    const unsigned G = gridDim.x * gridDim.y * gridDim.z;
    unsigned sum, cnt, mine, sp = 0u;
    for (;;) {
        sum = 0u; cnt = 0u; mine = 0u;
#pragma unroll
        for (unsigned j = 0; j < 16; ++j) { const unsigned c = xb_ld(&bar[XB_XCNT(j)]); sum += c; cnt += (c > 0u) ? 1u : 0u; mine = (j == x) ? c : mine; }
        if (sum == G) break;
        __builtin_amdgcn_s_sleep(1);
        if ((++sp & 255u) == 0u) { if (xb_ld(&bar[XB_TMO])) break; if (sp > XB_SPIN_CAP) { atomicAdd(&bar[XB_TMO], 1u); break; } }
    }
    nloc = mine > 0u ? mine : 1u; nx = cnt > 0u ? cnt : 1u;
}

__device__ __forceinline__ void xcd_barrier(const XcdBarrier& b) {
    asm volatile("s_waitcnt vmcnt(0)" ::: "memory");
    __syncthreads();
    if (b.wv == 0 && lane_id() == 0) {
        unsigned* bar = b.bar;
        __builtin_amdgcn_s_waitcnt(0);
        unsigned nloc = b.st[0], nx = b.st[1];
        if (nloc == 0u) { xcd_barrier_complete(bar, b.x, nloc, nx); b.st[0] = nloc; b.st[1] = nx; }
        const unsigned old = xb_add(&bar[XB_XSUB(b.x)], 1u);
        const unsigned gen = old / nloc;
        if (old + 1u == (gen + 1u) * nloc) {
            __builtin_amdgcn_fence(__ATOMIC_RELEASE, "agent");
            asm volatile("s_waitcnt vmcnt(0)" ::: "memory");
            const unsigned og = xb_add(&bar[XB_TOP], 1u);
            const unsigned tg = og / nx;
            if (og + 1u == (tg + 1u) * nx) xb_add(&bar[XB_TOPGEN], 1u);
            else XB_SPIN(xb_ld(&bar[XB_TOPGEN]) == tg, bar);
            __builtin_amdgcn_fence(__ATOMIC_ACQUIRE, "agent");
            xb_add(&bar[XB_XGEN(b.x)], 1u);
            asm volatile("s_waitcnt vmcnt(0)" ::: "memory");
        } else {
            XB_SPIN(xb_ld(&bar[XB_XGEN(b.x)]) == gen, bar);
            __builtin_amdgcn_fence(__ATOMIC_ACQUIRE, "agent");
            asm volatile("s_waitcnt vmcnt(0)" ::: "memory");
        }
    }
    __syncthreads();
}

constexpr size_t WS_BAR = 51 * MiB; constexpr int LDS_ST_OFF = 159744 - 256;
typedef const __attribute__((address_space(4))) Params* kparams_t;
DI Params load_params() {
  Params r{};
#if defined(__HIP_DEVICE_COMPILE__)
  kparams_t k = (kparams_t)__builtin_amdgcn_kernarg_segment_ptr(); asm volatile("" : "+s"(k));
  r.x = k->x; r.norm1_w = k->norm1_w; r.w_in = k->w_in; r.conv_w = k->conv_w; r.a_log = k->a_log; r.dt_bias = k->dt_bias; r.dn_norm_w = k->dn_norm_w; r.w_proj_a = k->w_proj_a;
  r.w_proj_b = k->w_proj_b; r.w_out = k->w_out; r.norm2_w = k->norm2_w; r.w_gate_up = k->w_gate_up; r.w_down = k->w_down; r.final_norm_w = k->final_norm_w; r.out = k->out; r.ws = k->ws;
#endif
  return r;
}
#define WSP (p.ws)
#define OBP ((unsigned char*)p.out)
#define WINP ((bf16_t*)(p.ws + WS_WIN))
__global__ void __launch_bounds__(512, 2) fwd_megakernel(Params p_unused) {
  extern __shared__ __attribute__((aligned(16))) unsigned char lds_raw[];
  cg::grid_group grid = cg::this_grid();
  lds_t lds = (lds_t)lds_raw;
  volatile LAS unsigned* st = (volatile LAS unsigned*)(lds + LDS_ST_OFF);
  if (threadIdx.x < 4) st[threadIdx.x] = 0u;
  __syncthreads();
  int wv = __builtin_amdgcn_readfirstlane((int)threadIdx.x >> 6); asm volatile("" : "+s"(wv));
  XcdBarrier bar;
  { const Params p = load_params(); bar = xcd_barrier_post((unsigned*)(p.ws + WS_BAR), st); bar.wv = wv; }
  { const Params p = load_params(); p0_prologue(p, lds, wv); } if (REP_P0 > 1) { const Params p = load_params(); p0_prologue(p, lds, wv); }
  if (wv < 0) grid.sync();
  xcd_barrier(bar);
  { const Params p = load_params(); GEMM_PHASE(EpiRope, OBP + DO_H1, WINP, 4608, 1024, (bf16_t*)(WSP + WS_AQKV), (const float*)(WSP + WS_ROPE)); }
#ifdef REP_G1
  { const Params p = load_params(); GEMM_PHASE(EpiRope, OBP + DO_H1, WINP, 4608, 1024, (bf16_t*)(WSP + WS_AQKV), (const float*)(WSP + WS_ROPE)); }
#endif
  xcd_barrier(bar);
  { const Params p = load_params(); attn_phase(p, lds, wv); } if (REP_ATTN > 1) { const Params p = load_params(); attn_phase(p, lds, wv); }
  xcd_barrier(bar);
  { const Params p = load_params(); combine_phase(p, wv); } if (REP_EW > 1) { const Params p = load_params(); combine_phase(p, wv); }
  { const Params p = load_params(); bg_phase(p, wv); }
  __syncthreads();
  { const Params p = load_params(); GEMM_PHASE(EpiDn, OBP + DO_H1, WINP + (size_t)4608 * 1024, 3072, 1024, (bf16_t*)(WSP + WS_DQKV), (float*)(WSP + WS_BG)); }
  xcd_barrier(bar);
  { const Params p = load_params(); chunkprep_wave(p, lds, wv); } if (REP_CP > 1) { const Params p = load_params(); chunkprep_wave(p, lds, wv); }
  xcd_barrier(bar);
  if (REP_SCAN > 1) { const Params p = load_params(); scan_phase<0>(p, lds, wv); }
  { const Params p = load_params(); scan_phase<1>(p, lds, wv); }
  xcd_barrier(bar);
  { const Params p = load_params(); GEMM_PHASE(EpiZG, OBP + DO_H1, WINP + (size_t)7936 * 1024, 3072, 1024, (bf16_t*)(WSP + WS_ZG)); }
  xcd_barrier(bar);
  { const Params p = load_params(); gate_phase(p, wv); } if (REP_EW > 1) { const Params p = load_params(); gate_phase(p, wv); }
  xcd_barrier(bar);
  { const Params p = load_params(); GEMM_PHASE(EpiYa, WSP + WS_OA, WSP + WS_WPA, 1024, 1024, (bf16_t*)(WSP + WS_PART), (const bf16_t*)(WSP + WS_ZG)); }
  { const Params p = load_params(); GEMM_PHASE(EpiYb, OBP + DO_OB, WSP + WS_WPB, 1024, 512, (const bf16_t*)(WSP + WS_PART), (const bf16_t*)(WSP + WS_ZG), (bf16_t*)(WSP + WS_MERGED)); }
  xcd_barrier(bar);
  { const Params p = load_params(); GEMM_PHASE(EpiResToB, WSP + WS_MERGED, WSP + WS_WOUT, 1024, 1024, p.x, (bf16_t*)(WSP + WS_X1)); }
#ifdef REP_G9
  { const Params p = load_params(); GEMM_PHASE(EpiResToB, WSP + WS_MERGED, WSP + WS_WOUT, 1024, 1024, p.x, (bf16_t*)(WSP + WS_X1)); }
#endif
  xcd_barrier(bar);
  { const Params p = load_params(); norm2_phase(p, wv); } if (REP_EW > 1) { const Params p = load_params(); norm2_phase(p, wv); }
  xcd_barrier(bar);
  { const Params p = load_params(); GEMM_PHASE(EpiSwiglu, WSP + WS_H2, WSP + WS_WGU, 5632, 1024, (bf16_t*)(WSP + WS_ACT)); } if (REP_GEMM > 1) { const Params p = load_params(); GEMM_PHASE(EpiSwiglu, WSP + WS_H2, WSP + WS_WGU, 5632, 1024, (bf16_t*)(WSP + WS_ACT)); }
  xcd_barrier(bar);
  { const Params p = load_params(); GEMM_PHASE(EpiResBB, WSP + WS_ACT, WSP + WS_WDN, 1024, FF_, (const bf16_t*)(WSP + WS_X1), (bf16_t*)(WSP + WS_X2B)); }
#ifdef REP_G12
  { const Params p = load_params(); GEMM_PHASE(EpiResBB, WSP + WS_ACT, WSP + WS_WDN, 1024, FF_, (const bf16_t*)(WSP + WS_X1), (bf16_t*)(WSP + WS_X2B)); }
#endif
  xcd_barrier(bar);
  { const Params p = load_params(); final_norm_phase(p, wv); }
}

extern "C" void kernel_launch(void* const* d_in, const int* in_sizes, int n_in, void* d_out, int out_size, void* d_ws, size_t ws_size, hipStream_t stream) {
  static int grid_blocks = 0;
  if (grid_blocks == 0) {
    if (n_in != 14 || out_size != T_ * D_ || ws_size < 8 * U_) { fprintf(stderr, "kernel_launch: unexpected shapes n_in %d out %d ws %zu\n", n_in, out_size, ws_size); grid_blocks = -1; return; }
    int dev = 0, cus = 0, per_cu = 0;
    (void)hipGetDevice(&dev); (void)hipDeviceGetAttribute(&cus, hipDeviceAttributeMultiprocessorCount, dev);
    if (hipFuncSetAttribute((const void*)fwd_megakernel, hipFuncAttributeMaxDynamicSharedMemorySize, LDS_BYTES) != hipSuccess) { fprintf(stderr, "hipFuncSetAttribute failed\n"); grid_blocks = -1; return; }
    if (hipOccupancyMaxActiveBlocksPerMultiprocessor(&per_cu, (const void*)fwd_megakernel, 512, LDS_BYTES) != hipSuccess || per_cu < 1) { fprintf(stderr, "occupancy query failed (%d)\n", per_cu); per_cu = 1; }
    (void)hipGetLastError();
    grid_blocks = cus * per_cu;
  }
  if (grid_blocks < 0) return;
  if (hipMemsetAsync((unsigned char*)d_ws + WS_BAR, 0, 16384, stream) != hipSuccess) { fprintf(stderr, "memset failed\n"); return; }
  Params p{};
  p.x = (const float*)d_in[0]; p.norm1_w = (const float*)d_in[1]; p.w_in = (const float*)d_in[2]; p.conv_w = (const float*)d_in[3]; p.a_log = (const float*)d_in[4];
  p.dt_bias = (const float*)d_in[5]; p.dn_norm_w = (const float*)d_in[6]; p.w_proj_a = (const float*)d_in[7]; p.w_proj_b = (const float*)d_in[8]; p.w_out = (const float*)d_in[9];
  p.norm2_w = (const float*)d_in[10]; p.w_gate_up = (const float*)d_in[11]; p.w_down = (const float*)d_in[12]; p.final_norm_w = (const float*)d_in[13];
  p.out = (float*)d_out; p.ws = (unsigned char*)d_ws;
  void* args[] = {&p};
  hipError_t e = hipLaunchCooperativeKernel((const void*)fwd_megakernel, dim3(grid_blocks), dim3(512), args, LDS_BYTES, stream);
  if (e != hipSuccess) fprintf(stderr, "cooperative launch failed: %s (grid %d)\n", hipGetErrorString(e), grid_blocks);
}
```
